# Optimizing an MI355X kernel written in HIP

```python
import math
import jax, jax.numpy as jnp
from jax import lax
import numpy as np

D_MODEL = 1024
BATCH = 1
SEQ = 16384
DEPTH = 2

N_MIXERS = 2
N_CONV = (DEPTH + 1) // 2
N_ATTN = DEPTH // 2
CONV_WIDTH = 3
HEAD_DIM = 64
N_HEADS = D_MODEL // HEAD_DIM
Q_BLOCK = 128
RMS_EPS = 1e-6

kernel_name = "hybrid_shortconv_forgetting_attention"


def _rmsnorm(x, g):
    xf = x.astype(jnp.float32)
    inv = lax.rsqrt(jnp.mean(xf * xf, axis=-1, keepdims=True) + RMS_EPS)
    return (xf * inv * g.astype(jnp.float32)).astype(x.dtype)


def _short_conv_layer(x, norm_g, w_in, conv_w, w_out):
    h = _rmsnorm(x, norm_g)
    proj = jnp.einsum('bsd,de->bse', h, w_in)
    b_g, c_g, xin, z = jnp.split(proj, 4, axis=-1)
    u = c_g * xin
    y = lax.conv_general_dilated(
        u, conv_w[:, None, :].astype(u.dtype),
        window_strides=(1,), padding=[(CONV_WIDTH - 1, 0)],
        dimension_numbers=('NWC', 'WIO', 'NWC'),
        feature_group_count=D_MODEL)
    y = b_g * y * jax.nn.silu(z)
    return x + jnp.einsum('bse,ed->bsd', y, w_out)


def _forgetting_attention(q, k, v, log_f):
    S = q.shape[2]
    c = jnp.cumsum(log_f, axis=-1)
    scale = 1.0 / math.sqrt(HEAD_DIM)
    kpos = jnp.arange(S)
    neg = jnp.finfo(jnp.float32).min

    def block(i):
        start = i * Q_BLOCK
        qb = lax.dynamic_slice_in_dim(q, start, Q_BLOCK, axis=2)
        cb = lax.dynamic_slice_in_dim(c, start, Q_BLOCK, axis=2)
        s = jnp.einsum('bhqd,bhkd->bhqk', qb, k) * scale
        s = s + cb[..., :, None] - c[..., None, :]
        qpos = start + jnp.arange(Q_BLOCK)
        s = jnp.where(kpos[None, :] <= qpos[:, None], s, neg)
        p = jax.nn.softmax(s, axis=-1)
        return jnp.einsum('bhqk,bhkd->bhqd', p, v)

    out = lax.map(block, jnp.arange(S // Q_BLOCK))
    nb, b, h, qn, dh = out.shape
    return jnp.transpose(out, (1, 2, 0, 3, 4)).reshape(b, h, nb * qn, dh)


def _attn_layer(x, norm_g, w_in, b_f, q_g, k_g, w_out):
    B, S, D = x.shape
    h = _rmsnorm(x, norm_g)
    proj = jnp.einsum('bsd,de->bse', h, w_in)
    q = proj[..., 0 * D:1 * D]
    k = proj[..., 1 * D:2 * D]
    v = proj[..., 2 * D:3 * D]
    z = proj[..., 3 * D:4 * D]
    f_logit = proj[..., 4 * D:].astype(jnp.float32) + b_f.astype(jnp.float32)
    to_heads = lambda t: jnp.transpose(t.reshape(B, S, N_HEADS, HEAD_DIM), (0, 2, 1, 3))
    q = _rmsnorm(to_heads(q), q_g).astype(jnp.float32)
    k = _rmsnorm(to_heads(k), k_g).astype(jnp.float32)
    v = to_heads(v).astype(jnp.float32)
    log_f = jnp.transpose(jax.nn.log_sigmoid(f_logit), (0, 2, 1))
    o = _forgetting_attention(q, k, v, log_f)
    o = jnp.transpose(o, (0, 2, 1, 3)).reshape(B, S, D).astype(x.dtype)
    o = o * jax.nn.silu(z)
    return x + jnp.einsum('bse,ed->bsd', o, w_out)


def setup_inputs(seed: int = 0) -> dict:
    key = jax.random.key(seed)
    ks = jax.random.split(key, 12)
    D = D_MODEL
    s_d = D ** -0.5
    x = jax.random.normal(ks[0], (BATCH, SEQ, D), jnp.float32)
    conv_norm_g = 1.0 + 0.02 * jax.random.normal(ks[1], (N_CONV, D), jnp.float32)
    conv_w_in = jax.random.normal(ks[2], (N_CONV, D, 4 * D), jnp.float32) * s_d
    conv_w = jax.random.normal(ks[3], (N_CONV, CONV_WIDTH, D), jnp.float32) * (CONV_WIDTH ** -0.5)
    conv_w_out = jax.random.normal(ks[4], (N_CONV, D, D), jnp.float32) * s_d
    attn_norm_g = 1.0 + 0.02 * jax.random.normal(ks[5], (N_ATTN, D), jnp.float32)
    attn_w_in = jax.random.normal(ks[6], (N_ATTN, D, 4 * D + N_HEADS), jnp.float32) * s_d
    attn_b_f = jax.random.uniform(ks[7], (N_ATTN, N_HEADS), jnp.float32, 1.0, 4.0)
    attn_q_norm_g = 1.0 + 0.02 * jax.random.normal(ks[8], (N_ATTN, HEAD_DIM), jnp.float32)
    attn_k_norm_g = 1.0 + 0.02 * jax.random.normal(ks[9], (N_ATTN, HEAD_DIM), jnp.float32)
    attn_w_out = jax.random.normal(ks[10], (N_ATTN, D, D), jnp.float32) * s_d
    return {"x": x, "conv_norm_g": conv_norm_g, "conv_w_in": conv_w_in, "conv_w": conv_w,
            "conv_w_out": conv_w_out, "attn_norm_g": attn_norm_g, "attn_w_in": attn_w_in,
            "attn_b_f": attn_b_f, "attn_q_norm_g": attn_q_norm_g, "attn_k_norm_g": attn_k_norm_g,
            "attn_w_out": attn_w_out}


def reference(x, conv_norm_g, conv_w_in, conv_w, conv_w_out, attn_norm_g, attn_w_in,
              attn_b_f, attn_q_norm_g, attn_k_norm_g, attn_w_out):
    for i in range(DEPTH):
        j = i // N_MIXERS
        if i % N_MIXERS == 0:
            x = _short_conv_layer(x, conv_norm_g[j], conv_w_in[j], conv_w[j], conv_w_out[j])
        else:
            x = _attn_layer(x, attn_norm_g[j], attn_w_in[j], attn_b_f[j],
                            attn_q_norm_g[j], attn_k_norm_g[j], attn_w_out[j])
    return x
```

```cpp
#include <hip/hip_runtime.h>
#include <hip/hip_cooperative_groups.h>
#include <cstdio>
#include <cstdint>
namespace cg = cooperative_groups;
namespace pg8 {
#define PG8_LAS __attribute__((address_space(3)))
typedef unsigned short bf16_t;
typedef short bf16x8 __attribute__((ext_vector_type(8)));
typedef float f32x4 __attribute__((ext_vector_type(4)));
typedef unsigned u32x4 __attribute__((ext_vector_type(4)));
constexpr int BM = 256, BK = 64, HALF = 128, HTB = HALF * BK * 2  , STAGE_BYTES = 8 * HTB, NXCD = 8, WGM = 8;

__host__ __device__ __forceinline__ int lds_byte(int r, int c) { const int st = (r >> 4) * 2 + (c >> 5), rr = r & 15, cc = c & 31, ob = rr * 64 + cc * 2; return st * 1024 + (ob ^ (((ob >> 9) & 1) << 5)); }
__host__ __device__ __forceinline__ void stage_rc(int b, int& R, int& C) { const int st = b / 1024, sb = b % 1024, swz = sb ^ (((sb >> 9) & 1) << 5); R = (st >> 1) * 16 + swz / 64; C = (st & 1) * 32 + (swz % 64) / 2; }
__host__ __device__ __forceinline__ int perm32(int rho) { const int n = rho >> 4, i = rho & 15; return 8 * (i >> 2) + 4 * n + (i & 3); }

struct Unit { int pm, pn; };
struct Gemm { const bf16_t* A; const bf16_t* Bt; int M, N, K; };

struct StaticOrder {
    int nM, nN, nwg, G, c;
    __host__ __device__ void init(int M, int N, int G_, int c_) { nM = M / BM; nN = N / BM; nwg = nM * nN; G = G_; c = c_; }
    __host__ __device__ bool next(int i, Unit& u) const {
        const long L = (long)i * G + c; if (L >= nwg) return false;
        int wgid = (int)L; { const int q = nwg / NXCD, r = nwg % NXCD, xcd = wgid % NXCD, off = wgid / NXCD; wgid = (xcd < r ? xcd * (q + 1) : r * (q + 1) + (xcd - r) * q) + off; }
        const int nig = WGM * nN, gid = wgid / nig, fm = gid * WGM, gsz = (nM - fm) < WGM ? (nM - fm) : WGM;
        u.pm = fm + ((wgid % nig) % gsz); u.pn = (wgid % nig) / gsz; return true;
    }
    __device__ __forceinline__ void a_ready(const Unit&) const {}
    __device__ __forceinline__ void done(const Unit&) const {}
};


__device__ __forceinline__ unsigned cvt_pk_bf16(float lo, float hi) { unsigned r; asm volatile("v_cvt_pk_bf16_f32 %0, %1, %2" : "=v"(r) : "v"(lo), "v"(hi)); return r; }
typedef unsigned u32x2 __attribute__((ext_vector_type(2)));
__device__ __forceinline__ float sigmoid_f(float z) { return __builtin_amdgcn_rcpf(1.0f + __builtin_amdgcn_exp2f(-1.4426950408889634f * z)); }

template <int N> __device__ __forceinline__ float dpp_ror(float v) { return __builtin_bit_cast(float, __builtin_amdgcn_mov_dpp(__builtin_bit_cast(int, v), 0x120 + N, 0xf, 0xf, false)); }
struct EpiConvIn {
    static constexpr bool PERM = true, AFTER_DRAIN = false;
    bf16_t* Y; float* HU; float* HG; float* TU; const float* cw; PG8_LAS float* xb;
    __device__ __forceinline__ void operator()(const f32x4 (&acc)[2][2][4][2], const Unit& u, int wr, int wc, int fr, int fq) const {
        const int row0 = u.pm * BM + wr * 64 + fr, d0 = u.pn * 64 + wc * 16 + fq * 4, chl = wc * 16 + fq * 4;
        const f32x4 w0 = *(const f32x4*)(cw + d0), w1 = *(const f32x4*)(cw + 1024 + d0), w2 = *(const f32x4*)(cw + 2048 + d0);
#pragma unroll
        for (int ai = 0; ai < 2; ++ai) if (fr >= 14) { const f32x4 ut = acc[ai][0][3][1] * acc[ai][1][3][0];
            *(PG8_LAS f32x4*)(xb + ((2 * ai + wr) * 2 + (fr - 14)) * 64 + chl) = ut;
            if (ai == 1 && wr == 1) *(f32x4*)(TU + ((size_t)u.pm * 2 + (fr - 14)) * 1024 + d0) = ut; }
        asm volatile("s_waitcnt lgkmcnt(0)" ::: "memory"); __builtin_amdgcn_s_barrier(); asm volatile("" ::: "memory");
#pragma unroll
        for (int ai = 0; ai < 2; ++ai) { const int b = 2 * ai + wr; f32x4 up = (f32x4){0.f, 0.f, 0.f, 0.f};
#pragma unroll
            for (int m = 0; m < 4; ++m) { const int row = row0 + ai * HALF + m * 16;
                const f32x4 bq = acc[ai][0][m][0], c = acc[ai][0][m][1], xi = acc[ai][1][m][0], z = acc[ai][1][m][1];
                const f32x4 uu = c * xi; f32x4 g, p15 = (f32x4){0.f, 0.f, 0.f, 0.f}, p14 = p15, y;
#pragma unroll
                for (int e = 0; e < 4; ++e) g[e] = bq[e] * z[e] * sigmoid_f(z[e]);
                if (m == 0) { const int bp = b > 0 ? b - 1 : 0; p14 = *(const PG8_LAS f32x4*)(xb + (bp * 2 + 0) * 64 + chl); p15 = *(const PG8_LAS f32x4*)(xb + (bp * 2 + 1) * 64 + chl); }
#pragma unroll
                for (int e = 0; e < 4; ++e) { float u1 = dpp_ror<1>(uu[e]), u2 = dpp_ror<2>(uu[e]);
                    if (m == 0) { u1 = fr == 0 ? p15[e] : u1; u2 = fr == 0 ? p14[e] : (fr == 1 ? p15[e] : u2); }
                    else { const float q1 = dpp_ror<1>(up[e]), q2 = dpp_ror<2>(up[e]); u1 = fr == 0 ? q1 : u1; u2 = fr < 2 ? q2 : u2; }
                    y[e] = g[e] * (w0[e] * u2 + w1[e] * u1 + w2[e] * uu[e]); }
                up = uu;
                if (b == 0 && m == 0 && fr < 2) { *(f32x4*)(HU + ((size_t)u.pm * 2 + fr) * 1024 + d0) = uu; *(f32x4*)(HG + ((size_t)u.pm * 2 + fr) * 1024 + d0) = g; }
                else { u32x2 wy; wy.x = cvt_pk_bf16(y[0], y[1]); wy.y = cvt_pk_bf16(y[2], y[3]); *(u32x2*)(Y + (size_t)row * 1024 + d0) = wy; } } }
    }
};
struct EpiConvOut {
    static constexpr bool PERM = true, AFTER_DRAIN = false;
    const bf16_t* XN; const float* RMS0; const float* G0; bf16_t* X1B; float* SSQ;
    __device__ __forceinline__ void operator()(const f32x4 (&acc)[2][2][4][2], const Unit& u, int wr, int wc, int fr, int fq) const {
        const int row0 = u.pm * BM + wr * 64 + fr, col0 = u.pn * BM + wc * 32 + 8 * fq;
        f32x4 gi[2][2];
#pragma unroll
        for (int bj = 0; bj < 2; ++bj)
#pragma unroll
            for (int n = 0; n < 2; ++n) { const f32x4 gg = *(const f32x4*)(G0 + col0 + bj * HALF + n * 4); gi[bj][n] = (f32x4){1.0f / gg[0], 1.0f / gg[1], 1.0f / gg[2], 1.0f / gg[3]}; }
#pragma unroll
        for (int ai = 0; ai < 2; ++ai)
#pragma unroll
            for (int m = 0; m < 4; ++m) { const int row = row0 + ai * HALF + m * 16; float s = 0.f; const float rms = RMS0[row];
#pragma unroll
                for (int bj = 0; bj < 2; ++bj) { const size_t off = (size_t)row * 1024 + col0 + bj * HALF;
                    const u32x4 xw = *(const u32x4*)(XN + off);
                    const f32x4 x0 = {__uint_as_float(xw.x << 16), __uint_as_float(xw.x & 0xffff0000u), __uint_as_float(xw.y << 16), __uint_as_float(xw.y & 0xffff0000u)};
                    const f32x4 x1 = {__uint_as_float(xw.z << 16), __uint_as_float(xw.z & 0xffff0000u), __uint_as_float(xw.w << 16), __uint_as_float(xw.w & 0xffff0000u)};
                    const f32x4 v0 = x0 * gi[bj][0] * rms + acc[ai][bj][m][0], v1 = x1 * gi[bj][1] * rms + acc[ai][bj][m][1];
                    s += ((v0[0] * v0[0] + v0[1] * v0[1]) + (v0[2] * v0[2] + v0[3] * v0[3])) + ((v1[0] * v1[0] + v1[1] * v1[1]) + (v1[2] * v1[2] + v1[3] * v1[3]));
                    u32x4 w; w.x = cvt_pk_bf16(v0[0], v0[1]); w.y = cvt_pk_bf16(v0[2], v0[3]); w.z = cvt_pk_bf16(v1[0], v1[1]); w.w = cvt_pk_bf16(v1[2], v1[3]); *(u32x4*)(X1B + off) = w; }
                s += __shfl_xor(s, 16); s += __shfl_xor(s, 32);
                if (fq == 0) SSQ[(size_t)row * 16 + u.pn * 4 + wc] = s; }
    }
};
struct EpiAttnIn {
    static constexpr bool PERM = true, AFTER_DRAIN = false;
    bf16_t* Q; bf16_t* K; bf16_t* V; bf16_t* SZ; const float* SSQ; const float* gq; const float* gk; float qscale;
    __device__ __forceinline__ void operator()(const f32x4 (&acc)[2][2][4][2], const Unit& u, int wr, int wc, int fr, int fq) const {
        const int kind = u.pn >> 2, hb = (u.pn & 3) * 4 + wc, row0 = u.pm * BM + wr * 64 + fr, col0 = hb * 64 + 8 * fq;
        bf16_t* base = kind == 0 ? Q : kind == 1 ? K : kind == 2 ? V : SZ;
        const float* g = kind == 0 ? gq : gk; const float post = kind == 0 ? qscale : 1.0f;
        f32x4 gv[2][2];
#pragma unroll
        for (int bj = 0; bj < 2; ++bj)
#pragma unroll
            for (int n = 0; n < 2; ++n) gv[bj][n] = *(const f32x4*)(g + 32 * bj + 8 * fq + 4 * n);
        float rsv[2][4];
#pragma unroll
        for (int ai = 0; ai < 2; ++ai)
#pragma unroll
            for (int m = 0; m < 4; ++m) { const f32x4 sa = *((const f32x4*)(SSQ + (size_t)(row0 + ai * HALF + m * 16) * 16) + fq); rsv[ai][m] = (sa[0] + sa[1]) + (sa[2] + sa[3]); }
#pragma unroll
        for (int ai = 0; ai < 2; ++ai)
#pragma unroll
            for (int m = 0; m < 4; ++m) { float ss = rsv[ai][m]; ss += __shfl_xor(ss, 16); ss += __shfl_xor(ss, 32); rsv[ai][m] = __builtin_amdgcn_rsqf(ss * (1.0f / 1024.0f) + 1e-6f); }
#pragma unroll
        for (int ai = 0; ai < 2; ++ai)
#pragma unroll
            for (int m = 0; m < 4; ++m) { const int row = row0 + ai * HALF + m * 16;
                const float rs = rsv[ai][m];
                f32x4 v[2][2];
#pragma unroll
                for (int bj = 0; bj < 2; ++bj)
#pragma unroll
                    for (int n = 0; n < 2; ++n) v[bj][n] = acc[ai][bj][m][n] * rs;
                if (kind < 2) { float hs = 0.f;
#pragma unroll
                    for (int bj = 0; bj < 2; ++bj)
#pragma unroll
                        for (int n = 0; n < 2; ++n) { const f32x4 x = v[bj][n]; hs += (x[0] * x[0] + x[1] * x[1]) + (x[2] * x[2] + x[3] * x[3]); }
                    hs += __shfl_xor(hs, 16); hs += __shfl_xor(hs, 32);
                    const float r = __builtin_amdgcn_rsqf(hs * (1.0f / 64.0f) + 1e-6f) * post;
#pragma unroll
                    for (int bj = 0; bj < 2; ++bj)
#pragma unroll
                        for (int n = 0; n < 2; ++n) v[bj][n] = v[bj][n] * r * gv[bj][n];
                } else if (kind == 3) {
#pragma unroll
                    for (int bj = 0; bj < 2; ++bj)
#pragma unroll
                        for (int n = 0; n < 2; ++n)
#pragma unroll
                            for (int e = 0; e < 4; ++e) v[bj][n][e] = v[bj][n][e] * sigmoid_f(v[bj][n][e]);
                }
#pragma unroll
                for (int bj = 0; bj < 2; ++bj) { u32x4 w; w.x = cvt_pk_bf16(v[bj][0][0], v[bj][0][1]); w.y = cvt_pk_bf16(v[bj][0][2], v[bj][0][3]); w.z = cvt_pk_bf16(v[bj][1][0], v[bj][1][1]); w.w = cvt_pk_bf16(v[bj][1][2], v[bj][1][3]);
                    *(u32x4*)(base + (size_t)row * 1024 + col0 + 32 * bj) = w; } }
    }
};
struct EpiOut {
    static constexpr bool PERM = true, AFTER_DRAIN = false;
    const bf16_t* X1B; float* OUT;
    __device__ __forceinline__ void operator()(const f32x4 (&acc)[2][2][4][2], const Unit& u, int wr, int wc, int fr, int fq) const {
        const int row0 = u.pm * BM + wr * 64 + fr, col0 = u.pn * BM + wc * 32 + 8 * fq;
#pragma unroll
        for (int ai = 0; ai < 2; ++ai)
#pragma unroll
            for (int m = 0; m < 4; ++m)
#pragma unroll
                for (int bj = 0; bj < 2; ++bj) { const size_t off = (size_t)(row0 + ai * HALF + m * 16) * 1024 + col0 + bj * HALF; const u32x4 w = *(const u32x4*)(X1B + off);
                    const f32x4 b0 = {__uint_as_float(w.x << 16), __uint_as_float(w.x & 0xffff0000u), __uint_as_float(w.y << 16), __uint_as_float(w.y & 0xffff0000u)};
                    const f32x4 b1 = {__uint_as_float(w.z << 16), __uint_as_float(w.z & 0xffff0000u), __uint_as_float(w.w << 16), __uint_as_float(w.w & 0xffff0000u)};
                    __builtin_nontemporal_store(b0 + acc[ai][bj][m][0], (f32x4*)(OUT + off)); __builtin_nontemporal_store(b1 + acc[ai][bj][m][1], (f32x4*)(OUT + off + 4)); }
    }
};

template <class Epi, class Sched, bool ALIGN_EPI = false, bool SP2 = false>
__device__ __forceinline__ void gemm_phase(PG8_LAS unsigned char* lds, const Gemm g, const Sched& S, const Epi& E) {
    int tid_ = threadIdx.x; asm volatile("" : "+v"(tid_));
    const int tid = tid_, wid = __builtin_amdgcn_readfirstlane(tid >> 6), lane = tid & 63, wr = wid >> 2, wc = wid & 3, fr = lane & 15, fq = lane >> 4;
    const int K = g.K, nt = K / BK;
    unsigned voffA[2], voffB[2];
#pragma unroll
    for (int i = 0; i < 2; ++i) { int R, C; stage_rc(tid * 16 + i * 8192, R, C); const int Rb = Epi::PERM ? ((R & ~31) + perm32(R & 31)) : R;
        voffA[i] = (unsigned)(R * K + C) * 2u; voffB[i] = (unsigned)(Rb * K + C) * 2u; }
    const size_t kstep = (size_t)(BK * 2);
    const size_t hstep = (size_t)HALF * K * 2;
    const size_t tstep = 2 * hstep;
    const unsigned ldsw = (unsigned)wid * 1024u;
    const int aoff = lds_byte(wr * 64 + fr, fq * 8), boff = lds_byte(wc * 32 + fr, fq * 8);
#define PG8_SA(b, h) (((b) * 2 + (h)) * HTB)
#define PG8_SB(b, h) ((4 + (b) * 2 + (h)) * HTB)
#define PG8_STAGE(bufoff, gbase, voff) do { _Pragma("unroll") for (int _i = 0; _i < 2; ++_i) \
        __builtin_amdgcn_global_load_lds((const unsigned*)((const char*)(gbase) + (voff)[_i]), (PG8_LAS unsigned*)(lds + (bufoff) + ldsw + _i * 8192), 16, 0, 0); } while (0)
#define PG8_LDA(dst, b, h) do { _Pragma("unroll") for (int m = 0; m < 4; ++m) _Pragma("unroll") for (int k = 0; k < 2; ++k) dst[m][k] = *(const PG8_LAS bf16x8*)(lds + PG8_SA(b, h) + aoff + m * 2048 + k * 1024); } while (0)
#define PG8_LDB(dst, b, h) do { _Pragma("unroll") for (int n = 0; n < 2; ++n) _Pragma("unroll") for (int k = 0; k < 2; ++k) dst[n][k] = *(const PG8_LAS bf16x8*)(lds + PG8_SB(b, h) + boff + n * 2048 + k * 1024); } while (0)
#define PG8_MMA(ai, bj, At, Bt) do { __builtin_amdgcn_s_setprio(1); _Pragma("unroll") for (int m = 0; m < 4; ++m) _Pragma("unroll") for (int n = 0; n < 2; ++n) _Pragma("unroll") for (int k = 0; k < 2; ++k) \
        acc[ai][bj][m][n] = __builtin_amdgcn_mfma_f32_16x16x32_bf16(Bt[n][k], At[m][k], acc[ai][bj][m][n], 0, 0, 0); __builtin_amdgcn_s_setprio(0); } while (0)
#define PG8_WAIT_V(n) asm volatile("s_waitcnt vmcnt(" #n ")" ::: "memory")
#define PG8_WAIT_L(n) asm volatile("s_waitcnt lgkmcnt(" #n ")" ::: "memory")
#define PG8_BAR __builtin_amdgcn_s_barrier()
#define PG8_SCHED __builtin_amdgcn_sched_barrier(0)
    Unit cur, nxt; int ui = 0;
    if (!S.next(0, cur)) return;
    f32x4 acc[2][2][4][2];
#pragma unroll
    for (int a = 0; a < 2; ++a)
#pragma unroll
        for (int b = 0; b < 2; ++b)
#pragma unroll
            for (int m = 0; m < 4; ++m)
#pragma unroll
                for (int n = 0; n < 2; ++n) acc[a][b][m][n] = (f32x4){0.f, 0.f, 0.f, 0.f};
    bf16x8 At[4][2], B0[2][2], B1[2][2];
    const char* cA = (const char*)g.A + (size_t)cur.pm * tstep; const char* cB = (const char*)g.Bt + (size_t)cur.pn * tstep;
    S.a_ready(cur);
    if constexpr (SP2) {
        PG8_STAGE(PG8_SB(0, 0), cB, voffB); PG8_STAGE(PG8_SB(0, 1), cB + hstep, voffB); PG8_STAGE(PG8_SA(0, 0), cA, voffA); PG8_STAGE(PG8_SA(0, 1), cA + hstep, voffA);
        if (wr == 1) PG8_BAR;
        PG8_WAIT_V(2); PG8_BAR;
        PG8_STAGE(PG8_SB(1, 0), cB + kstep, voffB); PG8_STAGE(PG8_SA(1, 0), cA + kstep, voffA); PG8_STAGE(PG8_SB(1, 1), cB + hstep + kstep, voffB);
        PG8_WAIT_V(6); PG8_BAR;
    } else {
        PG8_STAGE(PG8_SB(0, 0), cB, voffB); PG8_STAGE(PG8_SA(0, 0), cA, voffA); PG8_STAGE(PG8_SB(0, 1), cB + hstep, voffB); PG8_STAGE(PG8_SA(0, 1), cA + hstep, voffA);
        if (wr == 1) PG8_BAR;
        PG8_WAIT_V(4); PG8_BAR;
        PG8_STAGE(PG8_SB(1, 0), cB + kstep, voffB); PG8_STAGE(PG8_SA(1, 0), cA + kstep, voffA); PG8_STAGE(PG8_SB(1, 1), cB + hstep + kstep, voffB);
        PG8_WAIT_V(6); PG8_BAR;
    }
    for (;;) {
        const bool has_next = S.next(ui + 1, nxt);
        const char* nA = has_next ? (const char*)g.A + (size_t)nxt.pm * tstep : cA; const char* nB = has_next ? (const char*)g.Bt + (size_t)nxt.pn * tstep : cB;
        for (int t = 0; t < nt; t += 2) {
            const bool last = (t == nt - 2);
            const char* a1 = cA + (size_t)(t + 1) * kstep;
            const char* a2 = last ? nA : cA + (size_t)(t + 2) * kstep; const char* b2 = last ? nB : cB + (size_t)(t + 2) * kstep;
            const char* a3 = a2 + kstep; const char* b3 = b2 + kstep;
            if (last && has_next) S.a_ready(nxt);
            if constexpr (SP2) {
            PG8_LDB(B0, 0, 0); PG8_LDB(B1, 0, 1); PG8_SCHED; PG8_LDA(At, 0, 0); PG8_STAGE(PG8_SA(1, 1), a1 + hstep, voffA);
            PG8_WAIT_V(8); PG8_WAIT_L(0); PG8_BAR; PG8_MMA(0, 0, At, B0); PG8_MMA(0, 1, At, B1); PG8_BAR; PG8_SCHED;
            PG8_LDA(At, 0, 1); PG8_STAGE(PG8_SB(0, 0), b2, voffB); PG8_STAGE(PG8_SB(0, 1), b2 + hstep, voffB); PG8_STAGE(PG8_SA(0, 0), a2, voffA);
            PG8_WAIT_V(8); PG8_WAIT_L(0); PG8_BAR; PG8_MMA(1, 0, At, B0); PG8_MMA(1, 1, At, B1); PG8_BAR; PG8_SCHED;
            PG8_LDB(B0, 1, 0); PG8_LDB(B1, 1, 1); PG8_SCHED; PG8_LDA(At, 1, 0); PG8_STAGE(PG8_SA(0, 1), a2 + hstep, voffA);
            PG8_WAIT_V(8); PG8_WAIT_L(0); PG8_BAR; PG8_MMA(0, 0, At, B0); PG8_MMA(0, 1, At, B1); PG8_BAR; PG8_SCHED;
            PG8_LDA(At, 1, 1); PG8_STAGE(PG8_SB(1, 0), b3, voffB); PG8_STAGE(PG8_SB(1, 1), b3 + hstep, voffB); PG8_STAGE(PG8_SA(1, 0), a3, voffA);
            PG8_WAIT_V(8); PG8_WAIT_L(0); PG8_BAR; PG8_MMA(1, 0, At, B0); PG8_MMA(1, 1, At, B1); PG8_BAR; PG8_SCHED;
            } else {
            PG8_LDB(B0, 0, 0); PG8_SCHED; PG8_LDA(At, 0, 0); PG8_STAGE(PG8_SA(1, 1), a1 + hstep, voffA);
            PG8_WAIT_L(8); PG8_BAR; PG8_WAIT_L(0); PG8_MMA(0, 0, At, B0); PG8_BAR; PG8_SCHED;
            PG8_LDB(B1, 0, 1); PG8_STAGE(PG8_SB(0, 0), b2, voffB);
            PG8_BAR; PG8_WAIT_L(0); PG8_MMA(0, 1, At, B1); PG8_BAR;
            PG8_LDA(At, 0, 1); PG8_STAGE(PG8_SA(0, 0), a2, voffA);
            PG8_BAR; PG8_WAIT_L(0); PG8_MMA(1, 0, At, B0); PG8_BAR; PG8_SCHED;
            PG8_STAGE(PG8_SB(0, 1), b2 + hstep, voffB);
            PG8_WAIT_V(6); PG8_BAR; PG8_MMA(1, 1, At, B1); PG8_BAR;
            PG8_LDB(B0, 1, 0); PG8_SCHED; PG8_LDA(At, 1, 0); PG8_STAGE(PG8_SA(0, 1), a2 + hstep, voffA);
            PG8_WAIT_L(8); PG8_BAR; PG8_WAIT_L(0); PG8_MMA(0, 0, At, B0); PG8_BAR; PG8_SCHED;
            PG8_LDB(B1, 1, 1); PG8_STAGE(PG8_SB(1, 0), b3, voffB);
            PG8_BAR; PG8_WAIT_L(0); PG8_MMA(0, 1, At, B1); PG8_BAR;
            PG8_LDA(At, 1, 1); PG8_STAGE(PG8_SA(1, 0), a3, voffA);
            PG8_BAR; PG8_WAIT_L(0); PG8_MMA(1, 0, At, B0); PG8_BAR; PG8_SCHED;
            PG8_STAGE(PG8_SB(1, 1), b3 + hstep, voffB);
            PG8_WAIT_V(6); PG8_BAR; PG8_MMA(1, 1, At, B1); PG8_BAR;
            }
        }
        if constexpr (ALIGN_EPI) { if (wr == 0) PG8_BAR; }
        if constexpr (!Epi::AFTER_DRAIN) { E(acc, cur, wr, wc, fr, fq); S.done(cur); }
        if (!has_next) break;
#pragma unroll
        for (int a = 0; a < 2; ++a)
#pragma unroll
            for (int b = 0; b < 2; ++b)
#pragma unroll
                for (int m = 0; m < 4; ++m)
#pragma unroll
                    for (int n = 0; n < 2; ++n) acc[a][b][m][n] = (f32x4){0.f, 0.f, 0.f, 0.f};
        cur = nxt; cA = nA; cB = nB; ++ui;
        if constexpr (ALIGN_EPI) { if (wr == 1) PG8_BAR; }
    }
    PG8_WAIT_V(0);
    if constexpr (!ALIGN_EPI) { if (wr == 0) PG8_BAR; }
    PG8_BAR;
    if constexpr (Epi::AFTER_DRAIN) { E.fused(acc, cur, wr, wc, fr, fq, lds, wid, lane); S.done(cur); }
#undef PG8_SA
#undef PG8_SB
#undef PG8_STAGE
#undef PG8_LDA
#undef PG8_LDB
#undef PG8_MMA
#undef PG8_WAIT_V
#undef PG8_WAIT_L
#undef PG8_BAR
#undef PG8_SCHED
}
}
#include <hip/hip_bf16.h>
#include <cmath>
namespace attn_body {
using bf16=__hip_bfloat16;
using bf16x8=__attribute__((ext_vector_type(8)))short;
using s16x4=__attribute__((ext_vector_type(4)))short;
using f32x16=__attribute__((ext_vector_type(16)))float;
using u32x4=__attribute__((ext_vector_type(4)))unsigned;
constexpr int BATCH=1,NHEAD=16,SEQ=16384,D=64,DM=NHEAD*D;
constexpr int NW=8,QBLK=32,QB=QBLK*NW,KVBLK=64,NQB=SEQ/QB;
constexpr int ATTN_PITCH=DM, ATTN_UNIT_ROWS=QB, NUNITS=NHEAD*NQB;
typedef __attribute__((address_space(3))) const char* lds_cptr;
__device__ __forceinline__ int crow(int r,int hi){return (r&3)+8*(r>>2)+4*hi;}
#define SBAR() __builtin_amdgcn_sched_barrier(0)
__device__ __forceinline__ void cmask(f32x16&p0,f32x16&p1,int jb,int qrel,int hi){
  const float NEG=-INFINITY; int kb=64*jb+4*hi;
  #pragma unroll
  for(int r=0;r<16;++r){int kv=kb+(r&3)+8*(r>>2); if(kv>qrel)p0[r]=NEG; if(kv+32>qrel)p1[r]=NEG;}
}

constexpr int NSLOT=3, SLOTB=8192;
constexpr int LDS_K=0, LDS_V=NSLOT*SLOTB, LDS_WS=2*NSLOT*SLOTB, LDS_OST=LDS_WS+NW*64*4, LDS_BYTES=LDS_OST+NW*4096, LDS_C2=LDS_BYTES, LDS_RT=LDS_C2+SEQ*4, LDS_ALL=LDS_RT+8192+64;
constexpr float C2=0.125f*1.4426950408889634f;
__device__ __forceinline__ void glds16(const void*gsrc,unsigned lds_dst){unsigned keep;
  asm volatile("s_mov_b32 %0, m0\n\ts_mov_b32 m0, %2\n\ts_nop 0\n\tglobal_load_lds_dwordx4 %1, off\n\ts_mov_b32 m0, %0":"=&s"(keep):"v"(gsrc),"s"(lds_dst):"memory");}
__device__ __forceinline__ float max3f(float a,float b,float c){float r;asm("v_max3_f32 %0, %1, %2, %3":"=v"(r):"v"(a),"v"(b),"v"(c));return r;}
__device__ __forceinline__ float max2f(float a,float b){float r;asm("v_max_f32_e32 %0, %1, %2":"=v"(r):"v"(a),"v"(b));return r;}
__device__ __forceinline__ float fadd_s(float a,float b){float r;asm("v_add_f32_e32 %0, %1, %2":"=v"(r):"v"(a),"v"(b));return r;}
__device__ __forceinline__ float fsub_s(float a,float b){float r;asm("v_sub_f32_e32 %0, %1, %2":"=v"(r):"v"(a),"v"(b));return r;}
typedef float f32x2_t __attribute__((ext_vector_type(2))); typedef __bf16 bf16x2_t __attribute__((ext_vector_type(2)));
__device__ __forceinline__ unsigned cvtpk_s(float lo,float hi){f32x2_t v={lo,hi};bf16x2_t b=__builtin_convertvector(v,bf16x2_t);return __builtin_bit_cast(unsigned,b);}
#define WAIT_BAR(N) asm volatile("s_waitcnt vmcnt(" #N ") lgkmcnt(0)\n\ts_barrier":::"memory")

__device__ __forceinline__ void qkt(f32x16&p0,f32x16&p1,const char*Kslot,const bf16x8*qr,const f32x16&negm,int r32,int hi){
  const char*kb=Kslot+hi*1024+r32*16;
  #pragma unroll
  for(int d0=0;d0<4;++d0){
    const bf16x8 b0=*reinterpret_cast<const bf16x8*>(kb+d0*2048);
    const bf16x8 b1=*reinterpret_cast<const bf16x8*>(kb+d0*2048+512);
    if(d0==0){p0=__builtin_amdgcn_mfma_f32_32x32x16_bf16(b0,qr[0],negm,0,0,0);p1=__builtin_amdgcn_mfma_f32_32x32x16_bf16(b1,qr[0],negm,0,0,0);}
    else{p0=__builtin_amdgcn_mfma_f32_32x32x16_bf16(b0,qr[d0],p0,0,0,0);p1=__builtin_amdgcn_mfma_f32_32x32x16_bf16(b1,qr[d0],p1,0,0,0);}}
}
typedef short v4i16_t __attribute__((ext_vector_type(4)));
__device__ __forceinline__ void kload8(bf16x8*kf,lds_cptr kp){
  kf[0]=*(const __attribute__((address_space(3))) bf16x8*)(kp);      kf[1]=*(const __attribute__((address_space(3))) bf16x8*)(kp+512);
  kf[2]=*(const __attribute__((address_space(3))) bf16x8*)(kp+2048); kf[3]=*(const __attribute__((address_space(3))) bf16x8*)(kp+2560);
  kf[4]=*(const __attribute__((address_space(3))) bf16x8*)(kp+4096); kf[5]=*(const __attribute__((address_space(3))) bf16x8*)(kp+4608);
  kf[6]=*(const __attribute__((address_space(3))) bf16x8*)(kp+6144); kf[7]=*(const __attribute__((address_space(3))) bf16x8*)(kp+6656);
}
__device__ __forceinline__ void kload2(bf16x8*kf,lds_cptr kp,int j){ kf[2*j]=*(const __attribute__((address_space(3))) bf16x8*)(kp+j*2048); kf[2*j+1]=*(const __attribute__((address_space(3))) bf16x8*)(kp+j*2048+512); }
__device__ __forceinline__ s16x4 vtr(lds_cptr p){ return __builtin_bit_cast(s16x4,__builtin_amdgcn_ds_read_tr16_b64_v4i16((__attribute__((address_space(3))) v4i16_t*)p)); }
__device__ __forceinline__ float rowmax(const f32x16&p0,const f32x16&p1){
  float a=max3f(p0[0],p0[1],p1[0]),b=max3f(p0[2],p0[3],p1[1]);a=max3f(a,p1[2],p1[3]);
  #pragma unroll
  for(int r=4;r<16;r+=4){a=max3f(a,p0[r],p0[r+1]);b=max3f(b,p0[r+2],p0[r+3]);a=max3f(a,p1[r],p1[r+1]);b=max3f(b,p1[r+2],p1[r+3]);}
  const float m=max2f(a,b);
  auto rr=__builtin_amdgcn_permlane32_swap(__float_as_uint(m),__float_as_uint(m),false,false);
  return max2f(__uint_as_float(rr[0]),__uint_as_float(rr[1]));
}
__device__ __forceinline__ void pv(f32x16*o,int vb,bf16x8 pa0,bf16x8 pa1,bf16x8 pa2,bf16x8 pa3){
  #pragma unroll
  for(int d0=0;d0<2;++d0){s16x4 lo[4],hi[4];
    #pragma unroll
    for(int ks=0;ks<4;++ks){
      asm volatile("ds_read_b64_tr_b16 %0,%1 offset:%c2":"=&v"(lo[ks]):"v"(vb),"i"(d0*4096+ks*1024):"memory");
      asm volatile("ds_read_b64_tr_b16 %0,%1 offset:%c2":"=&v"(hi[ks]):"v"(vb),"i"(d0*4096+ks*1024+512):"memory");}
    asm volatile("s_waitcnt lgkmcnt(0)":::"memory");SBAR();
    #define PK(k) (bf16x8){lo[k][0],lo[k][1],lo[k][2],lo[k][3],hi[k][0],hi[k][1],hi[k][2],hi[k][3]}
    o[d0]=__builtin_amdgcn_mfma_f32_32x32x16_bf16(pa0,PK(0),o[d0],0,0,0);
    o[d0]=__builtin_amdgcn_mfma_f32_32x32x16_bf16(pa1,PK(1),o[d0],0,0,0);
    o[d0]=__builtin_amdgcn_mfma_f32_32x32x16_bf16(pa2,PK(2),o[d0],0,0,0);
    o[d0]=__builtin_amdgcn_mfma_f32_32x32x16_bf16(pa3,PK(3),o[d0],0,0,0);
    #undef PK
  }
}

#ifndef ATTN_STORE16
#define ATTN_STORE16(p,v) (*(u32x4*)(p)=(v))
#endif
typedef float f32x4v __attribute__((ext_vector_type(4)));
__device__ __forceinline__ void attn_tables(int h,int qb,const float*__restrict__ TOT,float negTH,int ui,char*shm,int lane){
  typedef __attribute__((address_space(3))) float lds_f; typedef __attribute__((address_space(3))) int lds_i;
  const lds_cptr shmL=(lds_cptr)shm; lds_f* rtab=(lds_f*)(shmL+LDS_RT)+ui*256; lds_i* tsw=(lds_i*)(shmL+LDS_RT+8192);
  const int j0=4*qb; const float* tp=TOT+h*(SEQ/KVBLK); const int base=j0-1-4*lane;
  const float v0=base>=0?tp[base>=0?base:0]:0.f, v1=base-1>=0?tp[base-1>=0?base-1:0]:0.f, v2=base-2>=0?tp[base-2>=0?base-2:0]:0.f, v3=base-3>=0?tp[base-3>=0?base-3:0]:0.f;
  const float s0=v0,s1=s0+v1,s2=s1+v2,s3=s2+v3; float inc=s3;
  _Pragma("unroll") for(int o=1;o<64;o<<=1){const float y=__shfl_up(inc,o); if(lane>=o)inc+=y;}
  const float off=inc-s3; const float S0=off+s0,S1=off+s1,S2=off+s2,S3=off+s3;
  int cnt=((base>=0&&(S0-v0)>=negTH)?1:0)+((base-1>=0&&(S1-v1)>=negTH)?1:0)+((base-2>=0&&(S2-v2)>=negTH)?1:0)+((base-3>=0&&(S3-v3)>=negTH)?1:0);
  _Pragma("unroll") for(int o=1;o<64;o<<=1)cnt+=__shfl_xor(cnt,o);
  if(base>=0)rtab[base]=-S0; if(base-1>=0)rtab[base-1]=-S1; if(base-2>=0)rtab[base-2]=-S2; if(base-3>=0)rtab[base-3]=-S3;
  if(lane==0){const float a=tp[j0],b2=tp[j0+1],c=tp[j0+2]; rtab[j0]=0.f; rtab[j0+1]=a; rtab[j0+2]=a+b2; rtab[j0+3]=a+b2+c; tsw[ui]=(j0-cnt)&~1;}
}
__device__ __forceinline__ void attn_tables_fin(int qb,float v0,float v1,float v2,float v3,float a,float b2,float c,float negTH,int ui,char*shm,int lane){
  typedef __attribute__((address_space(3))) float lds_f; typedef __attribute__((address_space(3))) int lds_i;
  const lds_cptr shmL=(lds_cptr)shm; lds_f* rtab=(lds_f*)(shmL+LDS_RT)+ui*256; lds_i* tsw=(lds_i*)(shmL+LDS_RT+8192);
  const int j0=4*qb; const int base=j0-1-4*lane;
  const float s0=v0,s1=s0+v1,s2=s1+v2,s3=s2+v3; float inc=s3;
  _Pragma("unroll") for(int o=1;o<64;o<<=1){const float y=__shfl_up(inc,o); if(lane>=o)inc+=y;}
  const float off=inc-s3; const float S0=off+s0,S1=off+s1,S2=off+s2,S3=off+s3;
  int cnt=((base>=0&&(S0-v0)>=negTH)?1:0)+((base-1>=0&&(S1-v1)>=negTH)?1:0)+((base-2>=0&&(S2-v2)>=negTH)?1:0)+((base-3>=0&&(S3-v3)>=negTH)?1:0);
  _Pragma("unroll") for(int o=1;o<64;o<<=1)cnt+=__shfl_xor(cnt,o);
  if(base>=0)rtab[base]=-S0; if(base-1>=0)rtab[base-1]=-S1; if(base-2>=0)rtab[base-2]=-S2; if(base-3>=0)rtab[base-3]=-S3;
  if(lane==0){ rtab[j0]=0.f; rtab[j0+1]=a; rtab[j0+2]=a+b2; rtab[j0+3]=a+b2+c; tsw[ui]=(j0-cnt)&~1;}
}
__device__ __forceinline__ int q_unit(int q,unsigned n){ return 8*(8*(int)(n>>3)+q)+(int)(n&7u); }
__device__ __forceinline__ int q_take(unsigned*ctr,int x,unsigned n){
  if(n<(unsigned)(NUNITS/8)) return q_unit(x,n);
  for(int t=1;t<8;++t){ const int q=(x+t)&7; const unsigned m=__hip_atomic_fetch_add(ctr+64*q,1u,__ATOMIC_RELAXED,__HIP_MEMORY_SCOPE_AGENT); if(m<(unsigned)(NUNITS/8)) return q_unit(q,m); }
  return NUNITS; }
__device__ __forceinline__ float bflo(unsigned w){return __uint_as_float(w<<16);} __device__ __forceinline__ float bfhi(unsigned w){return __uint_as_float(w&0xffff0000u);}
template<int THRL> __device__ __forceinline__ void attn_unit(int h,int qb,const bf16*Q,const bf16*__restrict__ K,const bf16*__restrict__ V,const bf16*__restrict__ SZ,bf16*O,const float*__restrict__ CL,int ui,unsigned*ctr,int xq,const float*__restrict__ TOT,float negTH,const __attribute__((address_space(3))) int*hor,char*shm){
  int tid_=threadIdx.x; asm volatile("":"+v"(tid_)); const int tid=tid_,lane=tid&63,r32=lane&31,hi=lane>>5; const int wid=__builtin_amdgcn_readfirstlane(tid>>6);
  const int q0=qb*QB;
  typedef __attribute__((address_space(3))) float lds_f; typedef __attribute__((address_space(3))) int lds_i;
  const lds_cptr shmL=(lds_cptr)shm;
  lds_f* c2l=(lds_f*)(shmL+LDS_C2); const lds_f* rtab=(const lds_f*)(shmL+LDS_RT)+ui*256; const lds_i* tsw=(const lds_i*)(shmL+LDS_RT+8192);
  const int ts=__builtin_amdgcn_readfirstlane(tsw[ui]);
  const lds_cptr c2p=shmL+LDS_C2+hi*16;
  const long rowbase=0;
  const bf16*Qw=Q+(long)(q0+wid*QBLK)*DM+h*D;
  const bf16*Kh=K+(long)ts*KVBLK*DM+h*D,*Vh=V+(long)ts*KVBLK*DM+h*D;
  #define INITLD(P0,P1,t) do{ const __attribute__((address_space(3))) f32x4v* cp_=(const __attribute__((address_space(3))) f32x4v*)(c2p+(t)*256); \
    _Pragma("unroll") for(int g_=0;g_<4;++g_){ const f32x4v a_=cp_[2*g_], b_=cp_[8+2*g_]; \
      P0[4*g_]=a_[0];P0[4*g_+1]=a_[1];P0[4*g_+2]=a_[2];P0[4*g_+3]=a_[3]; P1[4*g_]=b_[0];P1[4*g_+1]=b_[1];P1[4*g_+2]=b_[2];P1[4*g_+3]=b_[3]; } }while(0)
  #define INITSUB(P0,P1) do{ const float nm_=-mhat; _Pragma("unroll") for(int r=0;r<16;++r){P0[r]=nm_-P0[r];P1[r]=nm_-P1[r];} }while(0)
  #define CBIAS(P0,P1,t) do{ const __attribute__((address_space(3))) f32x4v* cp_=(const __attribute__((address_space(3))) f32x4v*)(c2p+(t)*256); \
    _Pragma("unroll") for(int g_=0;g_<4;++g_){ const f32x4v a_=cp_[2*g_], b_=cp_[8+2*g_]; \
      P0[4*g_]-=a_[0];P0[4*g_+1]-=a_[1];P0[4*g_+2]-=a_[2];P0[4*g_+3]-=a_[3]; P1[4*g_]-=b_[0];P1[4*g_+1]-=b_[1];P1[4*g_+2]-=b_[2];P1[4*g_+3]-=b_[3]; SBAR(); } }while(0)
  const unsigned lds0=(unsigned)(uintptr_t)shm;
  float*wsf=(float*)(shm+LDS_WS)+wid*64;
  const bf16*ksrc=Kh+(long)lane*DM+wid*8;
  const bf16*vsrc=Vh+(long)(16*(wid&3)+(lane>>2))*DM+(wid>>2)*32+(lane&3)*8;
  const unsigned kdst=lds0+LDS_K+wid*1024, vdst=lds0+LDS_V+wid*1024;
  #define DMA_K(t,slot) glds16(ksrc+(long)(t)*KVBLK*DM,(unsigned)__builtin_amdgcn_readfirstlane(kdst+(slot)))
  #define DMA_V(t,slot) glds16(vsrc+(long)(t)*KVBLK*DM,(unsigned)__builtin_amdgcn_readfirstlane(vdst+(slot)))
  const int vb0=(int)(lds0+LDS_V)+((lane>>4)&1)*32+(lane&3)*8+(4*hi+((lane&15)>>2))*64;
  const char*Kbase=shm+LDS_K; bf16x8 kf[8];
  const lds_cptr shm3=(lds_cptr)shm; const lds_cptr kp0=shm3+LDS_K+hi*1024+r32*16; const lds_cptr vp0=shm3+LDS_V+((lane>>4)&1)*32+(lane&3)*8+(4*hi+((lane&15)>>2))*64;
  const int NT=(q0+QB)/KVBLK-ts;
  DMA_K(0,0);DMA_V(0,0);DMA_K(1,SLOTB);
  bf16x8 qr[4];
  #pragma unroll
  for(int d0=0;d0<4;++d0)qr[d0]=*reinterpret_cast<const bf16x8*>(&Qw[(long)r32*DM+d0*16+hi*8]);
  float mhat=0.f,l_reg=0.f;f32x16 o[2];o[0]=f32x16{};o[1]=f32x16{};const f32x16 zero16=f32x16{};
  const int qrel=wid*QBLK+r32;
  #define CMASK(P0,P1,t) do{int jb_=(t)-(NT-4); if(jb_>=0)cmask(P0,P1,jb_,qrel,hi);}while(0)
  bool resc=false;
  #define START(P0,P1) do{ const float rm=rowmax(P0,P1); resc=false; \
    { const float dl=rm; mhat=fadd_s(mhat,dl); \
      _Pragma("unroll") for(int r=0;r<16;++r){P0[r]=fsub_s(P0[r],dl);P1[r]=fsub_s(P1[r],dl);} \
      } \
    _Pragma("unroll") for(int r=0;r<16;++r)P0[r]=__builtin_amdgcn_exp2f(P0[r]); }while(0)
  #define RESC() do{ if(resc){ asm volatile("s_waitcnt lgkmcnt(0)":::"memory"); \
      _Pragma("unroll") for(int d_=0;d_<2;++d_) _Pragma("unroll") for(int r=0;r<16;++r)o[d_][r]*=wsf[crow(r,hi)]; } }while(0)
  f32x16 pA0,pA1,pB0,pB1;
  int sl_prev=0,sl_cur=0,sl_next=SLOTB;
  #define ROT() do{sl_prev=sl_cur;sl_cur=sl_next;sl_next=(sl_next==(NSLOT-1)*SLOTB)?0:sl_next+SLOTB;}while(0)
  DMA_K(2,2*SLOTB);
  { const float* clp=CL+(long)h*SEQ+ts*KVBLK; const int n=(q0+QB)-ts*KVBLK;
    for(int i0=tid;i0<n;i0+=4*NW*64){ float cv[4];
      _Pragma("unroll") for(int j=0;j<4;++j){ const int i=i0+j*NW*64; cv[j]=clp[i<n?i:0]; }
      _Pragma("unroll") for(int j=0;j<4;++j){ const int i=i0+j*NW*64; if(i<n) c2l[i]=(cv[j]+rtab[(ts*KVBLK+i)>>6])*1.4426950408889634f; } } }
  unsigned nraw=0u; if(wid==0&&lane==0)nraw=__hip_atomic_fetch_add(ctr+64*xq,1u,__ATOMIC_RELAXED,__HIP_MEMORY_SCOPE_AGENT);
  WAIT_BAR(3);
  qkt(pA0,pA1,Kbase,qr,zero16,r32,hi);asm volatile("s_nop 15\n\ts_nop 7":"+v"(pA0),"+v"(pA1));CBIAS(pA0,pA1,0);CMASK(pA0,pA1,0);
  START(pA0,pA1);
  _Pragma("unroll") for(int r=0;r<16;++r)pA1[r]=__builtin_amdgcn_exp2f(pA1[r]);
  INITLD(pB0,pB1,1); INITSUB(pB0,pB1);
  WAIT_BAR(0);
  DMA_K(3,0);DMA_V(1,SLOTB);
  ROT();
  kload8(kf,kp0+sl_cur);
  WAIT_BAR(2);
  s16x4 vlo[8],vhi[8]; u32x4 pw0,pw1,pw2,pw3;
  #define PKW(P,B) cvtpk_s(P[B],P[B+1])
  #define PAF(k) __builtin_bit_cast(bf16x8,pw##k)
  #define VFR(i) (bf16x8){vlo[i][0],vlo[i][1],vlo[i][2],vlo[i][3],vhi[i][0],vhi[i][1],vhi[i][2],vhi[i][3]}
  #define PIN(x) asm volatile("":"+v"(x))
  #define MX3(a,b,c) __builtin_fmaxf(__builtin_fmaxf((a),(b)),(c))
  #define GAPA(MF,A0,A1,A2,A3,W0,W1,PW) do{ MF; sacc+=A0; sacc+=A1; sacc+=A2; sacc+=A3; PIN(sacc); W0; W1; PIN(PW); SBAR(); }while(0)
  #define EX(v) __builtin_amdgcn_exp2f(v)
  #define GAPB(MF,X,B) do{ MF; X[B]=EX(X[B]); X[B+1]=EX(X[B+1]); X[B+2]=EX(X[B+2]); X[B+3]=EX(X[B+3]); PIN(X); SBAR(); }while(0)
  #define VRD(i) do{ vlo[i]=vtr(vp_+(((i)>>2)*4096+((i)&3)*1024)); vhi[i]=vtr(vp_+(((i)>>2)*4096+((i)&3)*1024+512)); }while(0)
  #define KRD(G,j) do{ if(G){ kload2(kf,kp0+sl_next,j); SBAR(); } }while(0)
  #define STEP(C0,C1,P0,P1,t,GK,GV,GL,ZL) do{ SBAR(); \
    const lds_cptr vp_=vp0+sl_prev; \
    VRD(0); SBAR(); float sacc=(P0[0]+P0[1]); \
    GAPA(C0=__builtin_amdgcn_mfma_f32_32x32x16_bf16(kf[0],qr[0],C0,0,0,0), P0[2],P0[3],P0[4],P0[5],     pw0[0]=PKW(P0,0), pw0[1]=PKW(P0,2), pw0); \
    VRD(4); SBAR(); GAPA(C1=__builtin_amdgcn_mfma_f32_32x32x16_bf16(kf[1],qr[0],C1,0,0,0), P0[6],P0[7],P0[8],P0[9],     pw0[2]=PKW(P0,4), pw0[3]=PKW(P0,6), pw0); \
    VRD(1); SBAR(); GAPA(C0=__builtin_amdgcn_mfma_f32_32x32x16_bf16(kf[2],qr[1],C0,0,0,0),   P0[10],P0[11],P0[12],P0[13], pw1[0]=PKW(P0,8), pw1[1]=PKW(P0,10), pw1); \
    VRD(5); SBAR(); GAPA(C1=__builtin_amdgcn_mfma_f32_32x32x16_bf16(kf[3],qr[1],C1,0,0,0),   P0[14],P0[15],P1[0],P1[1],   pw1[2]=PKW(P0,12),pw1[3]=PKW(P0,14), pw1); \
    VRD(2); SBAR(); GAPA(C0=__builtin_amdgcn_mfma_f32_32x32x16_bf16(kf[4],qr[2],C0,0,0,0),   P1[2],P1[3],P1[4],P1[5],     pw2[0]=PKW(P1,0), pw2[1]=PKW(P1,2), pw2); \
    VRD(6); SBAR(); GAPA(C1=__builtin_amdgcn_mfma_f32_32x32x16_bf16(kf[5],qr[2],C1,0,0,0),   P1[6],P1[7],P1[8],P1[9],     pw2[2]=PKW(P1,4), pw2[3]=PKW(P1,6), pw2); \
    VRD(3); SBAR(); GAPA(C0=__builtin_amdgcn_mfma_f32_32x32x16_bf16(kf[6],qr[3],C0,0,0,0),   P1[10],P1[11],P1[12],P1[13], pw3[0]=PKW(P1,8), pw3[1]=PKW(P1,10), pw3); \
    VRD(7); SBAR(); GAPA(C1=__builtin_amdgcn_mfma_f32_32x32x16_bf16(kf[7],qr[3],C1,0,0,0),   P1[14],P1[15],0.f,0.f,       pw3[2]=PKW(P1,12),pw3[3]=PKW(P1,14), pw3); \
    l_reg+=sacc; \
    if(GK){DMA_K((t)+3,sl_cur);} if(GV){DMA_V((t)+1,sl_next);} \
    CMASK(C0,C1,t); \
    { float a=MX3(C0[0],C0[1],C1[0]),b=MX3(C0[2],C0[3],C1[1]); a=MX3(a,C1[2],C1[3]); \
      _Pragma("unroll") for(int r=4;r<16;r+=4){a=MX3(a,C0[r],C0[r+1]);b=MX3(b,C0[r+2],C0[r+3]);a=MX3(a,C1[r],C1[r+1]);b=MX3(b,C1[r+2],C1[r+3]);} \
      float rm=__builtin_fmaxf(a,b); { auto rr=__builtin_amdgcn_permlane32_swap(__float_as_uint(rm),__float_as_uint(rm),false,false); rm=__builtin_fmaxf(__uint_as_float(rr[0]),__uint_as_float(rr[1])); } \
      resc=false; \
      if(__builtin_expect(__any(rm>(float)THRL),0)){ const float dl=__builtin_fmaxf(rm,0.f); mhat+=dl; \
        _Pragma("unroll") for(int r=0;r<16;++r){C0[r]-=dl;C1[r]-=dl;} \
        const float f=__builtin_amdgcn_exp2f(-dl); l_reg*=f; if(hi==0)wsf[r32]=f; resc=true; } } \
    SBAR(); \
    if(GL){INITLD(P0,P1,(t)+1);} if(ZL){ _Pragma("unroll") for(int i_=0;i_<4;++i_) zg[i_]=*(const u32x4*)(Zw+(long)(i_*8)*DM); } SBAR(); \
    GAPB(o[0]=__builtin_amdgcn_mfma_f32_32x32x16_bf16(PAF(0),VFR(0),o[0],0,0,0), C0,0); \
    GAPB(o[1]=__builtin_amdgcn_mfma_f32_32x32x16_bf16(PAF(0),VFR(4),o[1],0,0,0), C0,4); \
    KRD(GL,0); GAPB(o[0]=__builtin_amdgcn_mfma_f32_32x32x16_bf16(PAF(1),VFR(1),o[0],0,0,0), C0,8); \
    KRD(GL,1); GAPB(o[1]=__builtin_amdgcn_mfma_f32_32x32x16_bf16(PAF(1),VFR(5),o[1],0,0,0), C0,12); \
    KRD(GL,2); GAPB(o[0]=__builtin_amdgcn_mfma_f32_32x32x16_bf16(PAF(2),VFR(2),o[0],0,0,0), C1,0); \
    KRD(GL,3); GAPB(o[1]=__builtin_amdgcn_mfma_f32_32x32x16_bf16(PAF(2),VFR(6),o[1],0,0,0), C1,4); \
    GAPB(o[0]=__builtin_amdgcn_mfma_f32_32x32x16_bf16(PAF(3),VFR(3),o[0],0,0,0), C1,8); \
    GAPB(o[1]=__builtin_amdgcn_mfma_f32_32x32x16_bf16(PAF(3),VFR(7),o[1],0,0,0), C1,12); \
    if(GL){INITSUB(P0,P1);} \
    }while(0)
  u32x4 zg[4]; const bf16*Zw=nullptr;
  int t=1;
  #undef CMASK
  #define CMASK(P0,P1,t) do{}while(0)
  for(;t+5<NT;t+=2){
    STEP(pB0,pB1,pA0,pA1,t,true,true,true,false);     WAIT_BAR(2); RESC(); ROT();
    STEP(pA0,pA1,pB0,pB1,t+1,true,true,true,false);   WAIT_BAR(2); RESC(); ROT();
  }
  #undef CMASK
  #define CMASK(P0,P1,t) do{int jb_=(t)-(NT-4); if(jb_>=0)cmask(P0,P1,jb_,qrel,hi);}while(0)
  #define ENDW(tt) do{ if((tt)+3<NT){WAIT_BAR(2);} else if((tt)+2<NT){WAIT_BAR(1);} else {WAIT_BAR(0);} }while(0)
  for(;t+1<NT;t+=2){
    STEP(pB0,pB1,pA0,pA1,t,(t+3<NT),(t+1<NT),(t+1<NT),false);       ENDW(t);   RESC(); ROT();
    STEP(pA0,pA1,pB0,pB1,t+1,(t+4<NT),(t+2<NT),(t+2<NT),false);     ENDW(t+1); RESC(); ROT();
  }
  int lane_e=lane; asm volatile("":"+v"(lane_e)); const long eoff=(long)(lane_e>>3)*DM+(lane_e&7)*8;
  Zw=SZ+(rowbase+q0+wid*QBLK)*DM+h*D+eoff;
  STEP(pB0,pB1,pA0,pA1,NT-1,false,false,false,true); RESC();
  int nxt_=NUNITS,qbn_=0; float tv0=0.f,tv1=0.f,tv2=0.f,tv3=0.f,ta=0.f,tb=0.f,tc=0.f;
  if(wid==0){ int nx_=NUNITS; if(lane==0)nx_=q_take(ctr,xq,nraw); nxt_=__builtin_amdgcn_readfirstlane(nx_);
    if(nxt_<NUNITS){ const int hn_=__builtin_amdgcn_readfirstlane(hor[nxt_>>6]); qbn_=(NQB-1)-(nxt_&(NQB-1));
      const float* tp=TOT+hn_*(SEQ/KVBLK); const int j0n=4*qbn_, base=j0n-1-4*lane;
      tv0=base>=0?tp[base>=0?base:0]:0.f; tv1=base-1>=0?tp[base-1>=0?base-1:0]:0.f; tv2=base-2>=0?tp[base-2>=0?base-2:0]:0.f; tv3=base-3>=0?tp[base-3>=0?base-3:0]:0.f;
      ta=tp[j0n]; tb=tp[j0n+1]; tc=tp[j0n+2]; } }
  { float sacc=pB0[0]+pB0[1]; _Pragma("unroll") for(int r=2;r<16;++r)sacc+=pB0[r]; _Pragma("unroll") for(int r=0;r<16;++r)sacc+=pB1[r]; l_reg+=sacc;
    pw0=(u32x4){PKW(pB0,0),PKW(pB0,2),PKW(pB0,4),PKW(pB0,6)};pw1=(u32x4){PKW(pB0,8),PKW(pB0,10),PKW(pB0,12),PKW(pB0,14)};pw2=(u32x4){PKW(pB1,0),PKW(pB1,2),PKW(pB1,4),PKW(pB1,6)};pw3=(u32x4){PKW(pB1,8),PKW(pB1,10),PKW(pB1,12),PKW(pB1,14)};
    SBAR(); pv(o,vb0+sl_cur,PAF(0),PAF(1),PAF(2),PAF(3)); }
  #undef PKW
  #undef PAF
  #undef VFR
  #undef PIN
  #undef MX3
  #undef GAPA
  #undef GAPB
  #undef EX
  #undef VRD
  #undef KRD
  #undef STEP
  #undef ENDW
  {auto rr=__builtin_amdgcn_permlane32_swap(__float_as_uint(l_reg),__float_as_uint(l_reg),false,false);l_reg=__uint_as_float(rr[0])+__uint_as_float(rr[1]);}
  if(hi==0)wsf[32+r32]=l_reg;asm volatile("s_waitcnt lgkmcnt(0)":::"memory");
  float rli[16];
  #pragma unroll
  for(int r=0;r<16;++r)rli[r]=__builtin_amdgcn_rcpf(wsf[32+crow(r,hi)]);
  bf16*Ow=O+(rowbase+q0+wid*QBLK)*DM+h*D+eoff;
  { bf16*stg=(bf16*)(shm+LDS_OST)+wid*2048;
    #pragma unroll
    for(int r=0;r<16;++r){const int orow=crow(r,hi);
      #pragma unroll
      for(int d0=0;d0<2;++d0)stg[orow*64+d0*32+r32]=__float2bfloat16(o[d0][r]*rli[r]);}
    asm volatile("s_waitcnt lgkmcnt(0)":::"memory");
    #pragma unroll
    for(int i=0;i<4;++i){const int row=i*8+(lane_e>>3),ch=lane_e&7; const u32x4 v=*(const u32x4*)(stg+row*64+ch*8); u32x4 w;
      _Pragma("unroll") for(int c=0;c<4;++c)w[c]=cvtpk_s(bflo(v[c])*bflo(zg[i][c]),bfhi(v[c])*bfhi(zg[i][c]));
      ATTN_STORE16(Ow+(long)(i*8)*DM,w);} }
  if(wid==0){ const int ns=ui^1;
    if(nxt_<NUNITS){ attn_tables_fin(qbn_,tv0,tv1,tv2,tv3,ta,tb,tc,negTH,ns,shm,lane); }
    if(lane==0)((__attribute__((address_space(3))) int*)((lds_cptr)shm+LDS_RT+8192+32))[ns]=nxt_; }
  asm volatile("s_waitcnt lgkmcnt(0)\n\ts_barrier":::"memory");
  #undef CBIAS
  #undef INITLD
  #undef INITSUB
  #undef DMA_K
  #undef DMA_V
  #undef CMASK
  #undef START
  #undef RESC
  #undef ROT
}
constexpr int ATTN_LDS_BYTES=LDS_ALL;
#undef SBAR
#undef WAIT_BAR
}
constexpr int NWAVES = 8;
constexpr int SEQ = 16384, D = 1024, H = 16, HD = 64, NIN = 4 * D, LDW3 = 4 * D + H;
constexpr float RMS_EPS = 1e-6f;
constexpr size_t MiB = 1u << 20;
constexpr size_t WS_CTL = 0, CTL_ZERO_BYTES = 16384; constexpr int CW_QUEUE = 3584;
constexpr size_t WS_W1 = 2 * MiB, WS_W2 = 10 * MiB, WS_W3 = 12 * MiB, WS_W4 = 20 * MiB, WS_WF = 22 * MiB, WS_SSQ = 23 * MiB, WS_CL = 24 * MiB, WS_TOT = 25 * MiB, WS_RMS0 = 25 * MiB + 512 * 1024, WS_HU = 26 * MiB, WS_HG = 27 * MiB, WS_TU = 28 * MiB;
constexpr size_t WS_XN = 32 * MiB, WS_U = 64 * MiB  , WS_GZ = 96 * MiB  , WS_Y = 128 * MiB, WS_X1B = 160 * MiB, WS_Q = 192 * MiB, WS_K = 224 * MiB, WS_END = 256 * MiB;
constexpr size_t WS_V = WS_U, WS_SZ = WS_GZ, WS_OG = WS_Y;
constexpr int RING_OFF = 0, RING_BYTES = 131072;
constexpr int LDS_BYTES = 160 * 1024;
static_assert(attn_body::ATTN_LDS_BYTES + 256 <= LDS_BYTES, "LDS map");
constexpr int HOR_OFF = attn_body::ATTN_LDS_BYTES;

#define GAS __attribute__((address_space(1)))
#define LAS __attribute__((address_space(3)))
typedef unsigned short bf16;
typedef unsigned v4u __attribute__((ext_vector_type(4)));
typedef float f32x4 __attribute__((ext_vector_type(4)));
typedef short bf16x8 __attribute__((ext_vector_type(8)));
#define LDS_WAIT() asm volatile("s_waitcnt lgkmcnt(0)" ::: "memory")
__device__ __forceinline__ unsigned f2bf(float f) { unsigned u = __builtin_bit_cast(unsigned, f); return (u + 0x7fffu + ((u >> 16) & 1u)) >> 16; }
__device__ __forceinline__ unsigned pk2(float lo, float hi) { return f2bf(lo) | (f2bf(hi) << 16); }
__device__ __forceinline__ float wave_sum(float v) {
#pragma unroll
    for (int o = 1; o < 64; o <<= 1) v += __shfl_xor(v, o);
    return v;
}
template <int MAP> __device__ __forceinline__ int colmap(int s) {
    if (MAP == 1) { const int mat = s >> 10, d = s & 1023; return 256 * (d >> 6) + 128 * (mat >> 1) + 32 * ((d >> 4) & 3) + 8 * ((d >> 2) & 3) + 4 * (mat & 1) + (d & 3); }
    if (MAP == 2) { return (s & ~255) + 128 * ((s >> 5) & 1) + 32 * ((s >> 6) & 3) + (s & 31); }
    return s;
}
template <int MAP> __device__ __forceinline__ void p0_transpose_item(const float* W, int K, int ldw, int N, const float* gk, bf16* WT, LAS float* scr, int item, int lane) {
    const int nblk = N / 32, kb = item / nblk, nb = item % nblk, k0 = 64 * kb, n0 = 32 * nb;
    { f32x4 w[8]; const int c4 = lane & 7, kr = lane >> 3;
#pragma unroll
      for (int i = 0; i < 8; ++i) w[i] = __builtin_nontemporal_load((const GAS f32x4*)(W + (size_t)(k0 + kr + 8 * i) * ldw + n0 + 4 * c4));
#pragma unroll
      for (int i = 0; i < 8; ++i) { const int kk = kr + 8 * i; f32x4 v = w[i]; if (gk) v = v * gk[k0 + kk];
          LAS float* d = scr + kk * 33 + 4 * c4; d[0] = v.x; d[1] = v.y; d[2] = v.z; d[3] = v.w; } }
    LDS_WAIT(); asm volatile("" ::: "memory");
    const int c = lane & 7;
#pragma unroll
    for (int j = 0; j < 4; ++j) { const int n = (lane >> 3) + 8 * j; const LAS float* s = scr + (8 * c) * 33 + n;
        v4u o; o.x = pk2(s[0 * 33], s[1 * 33]); o.y = pk2(s[2 * 33], s[3 * 33]); o.z = pk2(s[4 * 33], s[5 * 33]); o.w = pk2(s[6 * 33], s[7 * 33]);
        *(GAS v4u*)(WT + (size_t)colmap<MAP>(n0 + n) * K + k0 + 8 * c) = o; }
    LDS_WAIT(); asm volatile("" ::: "memory");
}
__device__ __forceinline__ void rms_row_to_bf16(const float* xrow, const float* g, bf16* orow, int lane) {
    const GAS f32x4* xr = (const GAS f32x4*)xrow + lane; const GAS f32x4* gr = (const GAS f32x4*)g + lane;
    f32x4 v[4]; float s = 0.f;
#pragma unroll
    for (int j = 0; j < 4; ++j) { v[j] = xr[64 * j]; s += (v[j].x * v[j].x + v[j].y * v[j].y) + (v[j].z * v[j].z + v[j].w * v[j].w); }
    const float inv = 1.f / sqrtf(wave_sum(s) * (1.f / D) + RMS_EPS);
    GAS unsigned long long* o8 = (GAS unsigned long long*)orow + lane;
#pragma unroll
    for (int j = 0; j < 4; ++j) { const f32x4 gg = gr[64 * j]; const f32x4 y = v[j] * inv * gg; o8[64 * j] = (unsigned long long)pk2(y.x, y.y) | ((unsigned long long)pk2(y.z, y.w) << 32); }
}
__device__ __forceinline__ void rms_4rows_to_bf16(const float* x0, const float* g, bf16* o0, size_t stride, int lane, float* rms_out, int rstride) {
    const GAS f32x4* gr = (const GAS f32x4*)g + lane;
    f32x4 v[4][4]; float s[4];
#pragma unroll
    for (int r = 0; r < 4; ++r)
#pragma unroll
        for (int j = 0; j < 4; ++j) v[r][j] = __builtin_nontemporal_load((const GAS f32x4*)(x0 + r * stride) + lane + 64 * j);
#pragma unroll
    for (int r = 0; r < 4; ++r) { float a = 0.f;
#pragma unroll
        for (int j = 0; j < 4; ++j) a += (v[r][j].x * v[r][j].x + v[r][j].y * v[r][j].y) + (v[r][j].z * v[r][j].z + v[r][j].w * v[r][j].w);
        const float ms = wave_sum(a) * (1.f / D) + RMS_EPS; s[r] = 1.f / sqrtf(ms); if (lane == 0) rms_out[r * rstride] = sqrtf(ms); }
#pragma unroll
    for (int j = 0; j < 4; ++j) { const f32x4 gg = gr[64 * j];
#pragma unroll
        for (int r = 0; r < 4; ++r) { const f32x4 y = v[r][j] * s[r] * gg; ((GAS unsigned long long*)(o0 + r * stride) + lane)[64 * j] = (unsigned long long)pk2(y.x, y.y) | ((unsigned long long)pk2(y.z, y.w) << 32); } }
}
__device__ __forceinline__ void rms_2rows_to_bf16(const float* xa, const float* xb, const float* g, bf16* oa, bf16* ob, int lane) {
    const GAS f32x4* ra = (const GAS f32x4*)xa + lane; const GAS f32x4* rb = (const GAS f32x4*)xb + lane; const GAS f32x4* gr = (const GAS f32x4*)g + lane;
    f32x4 va[4], vb[4]; float sa = 0.f, sb = 0.f;
#pragma unroll
    for (int j = 0; j < 4; ++j) { va[j] = ra[64 * j]; vb[j] = rb[64 * j]; }
#pragma unroll
    for (int j = 0; j < 4; ++j) { sa += (va[j].x * va[j].x + va[j].y * va[j].y) + (va[j].z * va[j].z + va[j].w * va[j].w); sb += (vb[j].x * vb[j].x + vb[j].y * vb[j].y) + (vb[j].z * vb[j].z + vb[j].w * vb[j].w); }
    const float ia = 1.f / sqrtf(wave_sum(sa) * (1.f / D) + RMS_EPS), ib = 1.f / sqrtf(wave_sum(sb) * (1.f / D) + RMS_EPS);
    GAS unsigned long long* o8a = (GAS unsigned long long*)oa + lane; GAS unsigned long long* o8b = (GAS unsigned long long*)ob + lane;
#pragma unroll
    for (int j = 0; j < 4; ++j) { const f32x4 gg = gr[64 * j]; const f32x4 ya = va[j] * ia * gg, yb = vb[j] * ib * gg;
        o8a[64 * j] = (unsigned long long)pk2(ya.x, ya.y) | ((unsigned long long)pk2(ya.z, ya.w) << 32); o8b[64 * j] = (unsigned long long)pk2(yb.x, yb.y) | ((unsigned long long)pk2(yb.z, yb.w) << 32); }
}
__device__ __forceinline__ float bf_lo(unsigned w) { return __uint_as_float(w << 16); }
__device__ __forceinline__ float bf_hi(unsigned w) { return __uint_as_float(w & 0xffff0000u); }

typedef GAS unsigned gu32;
#define RLX_AGENT __ATOMIC_RELAXED, __HIP_MEMORY_SCOPE_AGENT
#define XB_TMO      128
#define XB_XCNT(j)  (256  + 64 * (j))
#define XB_XSUB(j)  (1280 + 64 * (j))
#define XB_XGEN(j)  (2304 + 64 * (j))
#define XB_TOP      3328
#define XB_TOPGEN   3392
#define XCD_BAR_WORDS 3456
#define XB_SPIN_CAP (1u << 18)

__device__ __forceinline__ unsigned xb_ld(unsigned* p)              { return __hip_atomic_load(p, __ATOMIC_RELAXED, __HIP_MEMORY_SCOPE_AGENT); }
__device__ __forceinline__ unsigned xb_add(unsigned* p, unsigned v) { return __hip_atomic_fetch_add(p, v, __ATOMIC_RELAXED, __HIP_MEMORY_SCOPE_AGENT); }
__device__ __forceinline__ unsigned xb_xcc_id() { return (unsigned)__builtin_amdgcn_s_getreg((3 << 11) | 20) & 0xFu; }
#define XB_SPIN(cond, bar) do { unsigned _sp = 0; while (cond) { __builtin_amdgcn_s_sleep(1); \
    if ((++_sp & 255u) == 0u) { if (xb_ld(&(bar)[XB_TMO])) break; if (_sp > XB_SPIN_CAP) { atomicAdd(&(bar)[XB_TMO], 1u); break; } } } } while (0)

struct XcdBarrier {
    unsigned* bar; unsigned x;
    volatile LAS unsigned* st;
};

__device__ __forceinline__ XcdBarrier xcd_barrier_post(unsigned* bar, volatile LAS unsigned* st) {
    XcdBarrier b; b.bar = bar; b.x = xb_xcc_id(); b.st = st;
    if (threadIdx.x == 0) (void)xb_add(&bar[XB_XCNT(b.x)], 1u);
    return b;
}
__device__ __forceinline__ void xcd_barrier_complete(unsigned* bar, unsigned x, unsigned& nloc, unsigned& nx) {
    const unsigned G = gridDim.x * gridDim.y * gridDim.z;
    unsigned sum, cnt, mine, sp = 0u;
    for (;;) {
        sum = 0u; cnt = 0u; mine = 0u;
#pragma unroll
        for (unsigned j = 0; j < 16; ++j) { const unsigned c = xb_ld(&bar[XB_XCNT(j)]); sum += c; cnt += (c > 0u) ? 1u : 0u; mine = (j == x) ? c : mine; }
        if (sum == G) break;
        __builtin_amdgcn_s_sleep(1);
        if ((++sp & 255u) == 0u) { if (xb_ld(&bar[XB_TMO])) break; if (sp > XB_SPIN_CAP) { atomicAdd(&bar[XB_TMO], 1u); break; } }
    }
    nloc = mine > 0u ? mine : 1u; nx = cnt > 0u ? cnt : 1u;
}

__device__ __forceinline__ void xcd_barrier(const XcdBarrier& b) {
    asm volatile("s_waitcnt vmcnt(0)" ::: "memory");
    __syncthreads();
    if (threadIdx.x == 0) {
        unsigned* bar = b.bar;
        __builtin_amdgcn_s_waitcnt(0);
        unsigned nloc = b.st[0], nx = b.st[1];
        if (nloc == 0u) { xcd_barrier_complete(bar, b.x, nloc, nx); b.st[0] = nloc; b.st[1] = nx; }
        const unsigned old = xb_add(&bar[XB_XSUB(b.x)], 1u);
        const unsigned gen = old / nloc;
        if (old + 1u == (gen + 1u) * nloc) {
            __builtin_amdgcn_fence(__ATOMIC_RELEASE, "agent");
            asm volatile("s_waitcnt vmcnt(0)" ::: "memory");
            const unsigned og = xb_add(&bar[XB_TOP], 1u);
            const unsigned tg = og / nx;
            if (og + 1u == (tg + 1u) * nx) xb_add(&bar[XB_TOPGEN], 1u);
            else XB_SPIN(xb_ld(&bar[XB_TOPGEN]) == tg, bar);
            __builtin_amdgcn_fence(__ATOMIC_ACQUIRE, "agent");
            xb_add(&bar[XB_XGEN(b.x)], 1u);
            asm volatile("s_waitcnt vmcnt(0)" ::: "memory");
        } else {
            XB_SPIN(xb_ld(&bar[XB_XGEN(b.x)]) == gen, bar);
            __builtin_amdgcn_fence(__ATOMIC_ACQUIRE, "agent");
            asm volatile("s_waitcnt vmcnt(0)" ::: "memory");
        }
    }
    __syncthreads();
}

struct Args { const float* in[11]; float* out; unsigned char* ws; int cg_seams; int pad; };

__global__ void __launch_bounds__(NWAVES * 64, 2) fwd_megakernel(Args args) {
    extern __shared__ __attribute__((aligned(16))) unsigned char lds[];
    cg::grid_group grid = cg::this_grid();
    LAS unsigned char* ldsL = (LAS unsigned char*)lds;
    const int tid = threadIdx.x, lane = tid & 63, wave = __builtin_amdgcn_readfirstlane(tid >> 6);
    const int G = gridDim.x; const int bx = blockIdx.x; const int vcu = (G % 8 == 0) ? (bx % 8) * (G / 8) + bx / 8 : bx;
    unsigned char* ws = args.ws;
    const float* x = args.in[0]; const float* conv_norm_g = args.in[1]; const float* conv_w_in = args.in[2]; const float* conv_w = args.in[3]; const float* conv_w_out = args.in[4];
    const float* attn_norm_g = args.in[5]; const float* attn_w_in = args.in[6]; const float* attn_b_f = args.in[7]; const float* q_g = args.in[8]; const float* k_g = args.in[9]; const float* attn_w_out = args.in[10];
    float* out = args.out;
    bf16 *W1t = (bf16*)(ws + WS_W1), *W2t = (bf16*)(ws + WS_W2), *W3t = (bf16*)(ws + WS_W3), *W4t = (bf16*)(ws + WS_W4), *Wft = (bf16*)(ws + WS_WF);
    float *SSQ = (float*)(ws + WS_SSQ), *CL = (float*)(ws + WS_CL), *TOT = (float*)(ws + WS_TOT);
    bf16 *XN = (bf16*)(ws + WS_XN), *Y = (bf16*)(ws + WS_Y), *X1B = (bf16*)(ws + WS_X1B);
    float *RMS0 = (float*)(ws + WS_RMS0);
    float *HU = (float*)(ws + WS_HU), *HG = (float*)(ws + WS_HG), *TU = (float*)(ws + WS_TU);
    bf16 *Qb = (bf16*)(ws + WS_Q), *Kb = (bf16*)(ws + WS_K), *Vb = (bf16*)(ws + WS_V), *SZ = (bf16*)(ws + WS_SZ), *OG = (bf16*)(ws + WS_OG);

    volatile LAS unsigned* MISC = (volatile LAS unsigned*)(ldsL + LDS_BYTES - 64);
    if (tid == 0) { MISC[0] = 0u; MISC[1] = 0u; }
    __syncthreads();
    const XcdBarrier bar = xcd_barrier_post((unsigned*)(ws + WS_CTL), MISC);
    {
        LAS float* scr = (LAS float*)(ldsL + RING_OFF + wave * 16384);
        const int gw = vcu * NWAVES + wave, NGW = G * NWAVES;
        constexpr int I1 = (D / 64) * (NIN / 32), I2 = (D / 64) * (D / 32), I3 = I1, I4 = I2, NITEMS = I1 + I2 + I3 + I4;
        for (int it = gw; it < NITEMS; it += NGW) {
            int r = it;
            if (r < I1) { p0_transpose_item<1>(conv_w_in, D, NIN, NIN, nullptr, W1t, scr, r, lane); continue; } r -= I1;
            if (r < I2) { p0_transpose_item<0>(conv_w_out, D, D, D, nullptr, W2t, scr, r, lane); continue; } r -= I2;
            if (r < I3) { p0_transpose_item<2>(attn_w_in, D, LDW3, NIN, attn_norm_g, W3t, scr, r, lane); continue; } r -= I3;
            p0_transpose_item<0>(attn_w_out, D, D, D, nullptr, W4t, scr, r, lane);
        }
        for (int i = gw * 64 + lane; i < H * D; i += NGW * 64) { const int h = i >> 10, k = i & 1023; Wft[i] = (bf16)f2bf(attn_w_in[(size_t)k * LDW3 + NIN + h] * attn_norm_g[k]); }
        for (int m = gw; m < SEQ; m += 4 * NGW) rms_4rows_to_bf16(x + (size_t)m * D, conv_norm_g, XN + (size_t)m * D, (size_t)NGW * D, lane, RMS0 + m, NGW);
    }
    if (args.cg_seams) grid.sync(); else xcd_barrier(bar);

    {
        pg8::Gemm g{XN, W1t, SEQ, NIN, D}; pg8::StaticOrder S; S.init(SEQ, NIN, G, bx);
        pg8::EpiConvIn E{Y, HU, HG, TU, conv_w, (LAS float*)(ldsL + RING_BYTES)};
        pg8::gemm_phase<pg8::EpiConvIn, pg8::StaticOrder, true, true>(ldsL + RING_OFF, g, S, E);
    }
    if (args.cg_seams) grid.sync(); else xcd_barrier(bar);

    {
        pg8::Gemm g{Y, W2t, SEQ, D, D}; pg8::StaticOrder S; S.init(SEQ, D, G, bx);
        { pg8::Unit pu; for (int i = 0; S.next(i, pu); ++i) { const int r = tid >> 8, ch = (tid & 255) * 4, pm = pu.pm;
              const f32x4 u0 = *(const f32x4*)(HU + ((size_t)pm * 2 + 0) * D + ch), u1 = *(const f32x4*)(HU + ((size_t)pm * 2 + 1) * D + ch), gz = *(const f32x4*)(HG + ((size_t)pm * 2 + r) * D + ch);
              f32x4 t0 = (f32x4){0.f, 0.f, 0.f, 0.f}, t1 = t0; if (pm > 0) { t0 = *(const f32x4*)(TU + ((size_t)(pm - 1) * 2 + 0) * D + ch); t1 = *(const f32x4*)(TU + ((size_t)(pm - 1) * 2 + 1) * D + ch); }
              const f32x4 w0 = *(const f32x4*)(conv_w + ch), w1 = *(const f32x4*)(conv_w + D + ch), w2 = *(const f32x4*)(conv_w + 2 * D + ch);
              const f32x4 y = r == 0 ? gz * (w0 * t0 + w1 * t1 + w2 * u0) : gz * (w0 * t1 + w1 * u0 + w2 * u1);
              unsigned long long o = (unsigned long long)pk2(y.x, y.y) | ((unsigned long long)pk2(y.z, y.w) << 32);
              *(unsigned long long*)(Y + ((size_t)pm * 256 + r) * D + ch) = o; }
          asm volatile("s_waitcnt vmcnt(0)" ::: "memory"); __syncthreads(); }
        pg8::EpiConvOut E{XN, RMS0, conv_norm_g, X1B, SSQ};
        pg8::gemm_phase<pg8::EpiConvOut, pg8::StaticOrder, true, true>(ldsL + RING_OFF, g, S, E);
    }
    if (args.cg_seams) grid.sync(); else xcd_barrier(bar);

    {
        typedef float f32x4m __attribute__((ext_vector_type(4)));
        LAS float* part = (LAS float*)(ldsL + RING_OFF);
        for (int chunk = bx; chunk < SEQ / 64; chunk += G) {
            const int t0 = chunk * 64, fr = lane & 15, fq = lane >> 4;
            const f32x4* sp = (const f32x4*)(SSQ + (size_t)(t0 + lane) * 16); const f32x4 sa = sp[0], sb = sp[1], sc = sp[2], sd = sp[3];
            f32x4m acc[4];
#pragma unroll
            for (int rb = 0; rb < 4; ++rb) acc[rb] = (f32x4m){0.f, 0.f, 0.f, 0.f};
#pragma unroll
            for (int ks = 0; ks < 4; ++ks) { const int k0 = wave * 128 + ks * 32 + fq * 8;
                const bf16x8 b = *(const bf16x8*)(Wft + (size_t)fr * D + k0);
#pragma unroll
                for (int rb = 0; rb < 4; ++rb) { const bf16x8 a = *(const bf16x8*)(X1B + (size_t)(t0 + rb * 16 + fr) * D + k0); acc[rb] = __builtin_amdgcn_mfma_f32_16x16x32_bf16(a, b, acc[rb], 0, 0, 0); } }
#pragma unroll
            for (int rb = 0; rb < 4; ++rb)
#pragma unroll
                for (int j = 0; j < 4; ++j) part[(wave * 64 + rb * 16 + fq * 4 + j) * 16 + fr] = acc[rb][j];
            __syncthreads();
            { const int row = t0 + lane;
              const float ss = ((sa[0] + sa[1]) + (sa[2] + sa[3])) + ((sb[0] + sb[1]) + (sb[2] + sb[3])) + ((sc[0] + sc[1]) + (sc[2] + sc[3])) + ((sd[0] + sd[1]) + (sd[2] + sd[3]));
              const float rs = 1.f / sqrtf(ss * (1.0f / 1024.0f) + RMS_EPS);
#pragma unroll
              for (int hh = 0; hh < 2; ++hh) { const int h = 2 * wave + hh; float v = 0.f;
#pragma unroll
                  for (int w = 0; w < 8; ++w) v += part[(w * 64 + lane) * 16 + h];
                  const float logit = v * rs + attn_b_f[h];
                  float lf = fminf(logit, 0.f) - 0.6931471805599453f * __builtin_amdgcn_logf(1.0f + __builtin_amdgcn_exp2f(-1.4426950408889634f * fabsf(logit)));
#pragma unroll
                  for (int o = 1; o < 64; o <<= 1) { const float y = __shfl_up(lf, o); if (lane >= o) lf += y; }
                  CL[(size_t)h * SEQ + row] = lf; if (lane == 63) TOT[h * (SEQ / 64) + chunk] = lf; } }
            asm volatile("s_waitcnt lgkmcnt(0)" ::: "memory"); __builtin_amdgcn_s_barrier(); asm volatile("" ::: "memory");
        }
    }
    {
        pg8::Gemm g{X1B, W3t, SEQ, NIN, D}; pg8::StaticOrder S; S.init(SEQ, NIN, G, bx);
        pg8::EpiAttnIn E{Qb, Kb, Vb, SZ, SSQ, q_g, k_g, attn_body::C2};
        pg8::gemm_phase<pg8::EpiAttnIn, pg8::StaticOrder, true, true>(ldsL + RING_OFF, g, S, E);
    }
        LAS int* hor = (LAS int*)(ldsL + HOR_OFF);
        float mq = 0.f, mk = 0.f;
        for (int i = 0; i < HD; ++i) { mq = fmaxf(mq, fabsf(q_g[i])); mk = fmaxf(mk, fabsf(k_g[i])); }
        const float negTH = -(20.0f + 2.0f * 8.2f * mq * mk);
        if (tid < H) { const float me = attn_b_f[tid]; int rank = 0;
            for (int h2 = 0; h2 < H; ++h2) { const float o = attn_b_f[h2]; rank += ((o > me) || (o == me && h2 < tid)) ? 1 : 0; }
            hor[rank] = tid; }
        unsigned* ctr = (unsigned*)(ws + WS_CTL) + CW_QUEUE;
        const int xq = (int)(bar.x & 7u);
        unsigned first_raw = 0u; if (wave == 0 && lane == 0) first_raw = __hip_atomic_fetch_add(ctr + 64 * xq, 1u, __ATOMIC_RELAXED, __HIP_MEMORY_SCOPE_AGENT);
    if (args.cg_seams) grid.sync(); else xcd_barrier(bar);

    {
        LAS int* idw = (LAS int*)(ldsL + RING_OFF + attn_body::LDS_RT + 8192 + 32);
        if (wave == 0) { int nx_ = attn_body::NUNITS; if (lane == 0) nx_ = attn_body::q_take(ctr, xq, first_raw); const int nxt = __builtin_amdgcn_readfirstlane(nx_);
            if (nxt < attn_body::NUNITS) attn_body::attn_tables(__builtin_amdgcn_readfirstlane(hor[nxt >> 6]), 63 - (nxt & 63), TOT, negTH, 0, (char*)lds + RING_OFF, lane);
            if (lane == 0) idw[0] = nxt; }
        __syncthreads();
        for (int k = 0;; ++k) { const int cur = __builtin_amdgcn_readfirstlane(idw[k & 1]); if (cur >= attn_body::NUNITS) break;
            const int h = __builtin_amdgcn_readfirstlane(hor[cur >> 6]), qb = 63 - (cur & 63);
            attn_body::attn_unit<60>(h, qb, (const attn_body::bf16*)Qb, (const attn_body::bf16*)Kb, (const attn_body::bf16*)Vb, (const attn_body::bf16*)SZ, (attn_body::bf16*)OG, CL, k & 1, ctr, xq, TOT, negTH, hor, (char*)lds + RING_OFF); }
    }
    if (args.cg_seams) grid.sync(); else xcd_barrier(bar);

    {
        pg8::Gemm g{OG, W4t, SEQ, D, D}; pg8::StaticOrder S; S.init(SEQ, D, G, bx);
        pg8::EpiOut E{X1B, out};
        pg8::gemm_phase<pg8::EpiOut, pg8::StaticOrder, true, true>(ldsL + RING_OFF, g, S, E);
    }
}

extern "C" void kernel_launch(void* const* d_in, const int* in_sizes, int n_in, void* d_out, int out_size, void* d_ws, size_t ws_size, hipStream_t stream) {
    static int grid = 0;
    if (grid == 0) {
        if (n_in != 11 ||   false || in_sizes[0] != SEQ * D || out_size != SEQ * D || ws_size < WS_END) { fprintf(stderr, "kernel_launch: unexpected shapes (n_in %d, in0 %d, out %d, ws %zu); nothing launched\n", n_in, n_in > 0 ? in_sizes[0] : -1, out_size, ws_size); grid = -1; return; }
        int dev = 0, cus = 0, per_cu = 0;
        if (hipGetDevice(&dev) != hipSuccess || hipDeviceGetAttribute(&cus, hipDeviceAttributeMultiprocessorCount, dev) != hipSuccess) { grid = -1; return; }
        if (hipFuncSetAttribute((const void*)fwd_megakernel, hipFuncAttributeMaxDynamicSharedMemorySize, LDS_BYTES) != hipSuccess) { fprintf(stderr, "kernel_launch: hipFuncSetAttribute failed\n"); grid = -1; return; }
        if (hipOccupancyMaxActiveBlocksPerMultiprocessor(&per_cu, (const void*)fwd_megakernel, NWAVES * 64, LDS_BYTES) != hipSuccess || per_cu < 1) { fprintf(stderr, "kernel_launch: occupancy query says %d\n", per_cu); per_cu = 1; }
        (void)hipGetLastError();
        grid = cus; if (grid * NWAVES < H * (SEQ / 256)) { fprintf(stderr, "kernel_launch: needs >= 128 CUs\n"); grid = -1; return; }
    }
    if (grid < 0) return;
    if (hipMemsetAsync((char*)d_ws + WS_CTL, 0, CTL_ZERO_BYTES, stream) != hipSuccess) { fprintf(stderr, "kernel_launch: hipMemsetAsync failed\n"); return; }
    Args a{};
    for (int i = 0; i < 11; ++i) a.in[i] = (const float*)d_in[i];
    a.out = (float*)d_out; a.ws = (unsigned char*)d_ws; a.cg_seams = 0; a.pad = 0;
    void* kargs[] = {&a};
    hipError_t e = hipLaunchCooperativeKernel((const void*)fwd_megakernel, dim3(grid), dim3(NWAVES * 64), kargs, LDS_BYTES, stream);
    if (e != hipSuccess) fprintf(stderr, "kernel_launch: cooperative launch failed: %s (grid %d)\n", hipGetErrorString(e), grid);
}
```

```cpp
#include <hip/hip_runtime.h>
#include <hip/hip_cooperative_groups.h>
#include <cstdio>
#include <cstdint>
namespace cg = cooperative_groups;
namespace pg8 {
#define PG8_LAS __attribute__((address_space(3)))
typedef unsigned short bf16_t;
typedef short bf16x8 __attribute__((ext_vector_type(8)));
typedef float f32x4 __attribute__((ext_vector_type(4)));
typedef unsigned u32x4 __attribute__((ext_vector_type(4)));
constexpr int BM = 256, BK = 64, HALF = 128, HTB = HALF * BK * 2  , STAGE_BYTES = 8 * HTB, NXCD = 8, WGM = 8;

__host__ __device__ __forceinline__ int lds_byte(int r, int c) { const int st = (r >> 4) * 2 + (c >> 5), rr = r & 15, cc = c & 31, ob = rr * 64 + cc * 2; return st * 1024 + (ob ^ (((ob >> 9) & 1) << 5)); }
__host__ __device__ __forceinline__ void stage_rc(int b, int& R, int& C) { const int st = b / 1024, sb = b % 1024, swz = sb ^ (((sb >> 9) & 1) << 5); R = (st >> 1) * 16 + swz / 64; C = (st & 1) * 32 + (swz % 64) / 2; }
__host__ __device__ __forceinline__ int perm32(int rho) { const int n = rho >> 4, i = rho & 15; return 8 * (i >> 2) + 4 * n + (i & 3); }

struct Unit { int pm, pn; };
struct Gemm { const bf16_t* A; const bf16_t* Bt; int M, N, K; };

struct StaticOrder {
    int nM, nN, nwg, G, c;
    __host__ __device__ void init(int M, int N, int G_, int c_) { nM = M / BM; nN = N / BM; nwg = nM * nN; G = G_; c = c_; }
    __host__ __device__ bool next(int i, Unit& u) const {
        const long L = (long)i * G + c; if (L >= nwg) return false;
        int wgid = (int)L; { const int q = nwg / NXCD, r = nwg % NXCD, xcd = wgid % NXCD, off = wgid / NXCD; wgid = (xcd < r ? xcd * (q + 1) : r * (q + 1) + (xcd - r) * q) + off; }
        const int nig = WGM * nN, gid = wgid / nig, fm = gid * WGM, gsz = (nM - fm) < WGM ? (nM - fm) : WGM;
        u.pm = fm + ((wgid % nig) % gsz); u.pn = (wgid % nig) / gsz; return true;
    }
    __device__ __forceinline__ void a_ready(const Unit&) const {}
    __device__ __forceinline__ void done(const Unit&) const {}
};


__device__ __forceinline__ unsigned cvt_pk_bf16(float lo, float hi) { unsigned r; asm volatile("v_cvt_pk_bf16_f32 %0, %1, %2" : "=v"(r) : "v"(lo), "v"(hi)); return r; }
typedef unsigned u32x2 __attribute__((ext_vector_type(2)));
__device__ __forceinline__ float sigmoid_f(float z) { return __builtin_amdgcn_rcpf(1.0f + __builtin_amdgcn_exp2f(-1.4426950408889634f * z)); }

template <int N> __device__ __forceinline__ float dpp_ror(float v) { return __builtin_bit_cast(float, __builtin_amdgcn_mov_dpp(__builtin_bit_cast(int, v), 0x120 + N, 0xf, 0xf, false)); }
struct EpiConvIn {
    static constexpr bool PERM = true, AFTER_DRAIN = false;
    bf16_t* Y; float* HU; float* HG; float* TU; const float* cw; PG8_LAS float* xb;
    __device__ __forceinline__ void operator()(const f32x4 (&acc)[2][2][4][2], const Unit& u, int wr, int wc, int fr, int fq) const {
        const int row0 = u.pm * BM + wr * 64 + fr, d0 = u.pn * 64 + wc * 16 + fq * 4, chl = wc * 16 + fq * 4;
        const f32x4 w0 = *(const f32x4*)(cw + d0), w1 = *(const f32x4*)(cw + 1024 + d0), w2 = *(const f32x4*)(cw + 2048 + d0);
#pragma unroll
        for (int ai = 0; ai < 2; ++ai) if (fr >= 14) { const f32x4 ut = acc[ai][0][3][1] * acc[ai][1][3][0];
            *(PG8_LAS f32x4*)(xb + ((2 * ai + wr) * 2 + (fr - 14)) * 64 + chl) = ut;
            if (ai == 1 && wr == 1) *(f32x4*)(TU + ((size_t)u.pm * 2 + (fr - 14)) * 1024 + d0) = ut; }
        asm volatile("s_waitcnt lgkmcnt(0)" ::: "memory"); __builtin_amdgcn_s_barrier(); asm volatile("" ::: "memory");
#pragma unroll
        for (int ai = 0; ai < 2; ++ai) { const int b = 2 * ai + wr; f32x4 up = (f32x4){0.f, 0.f, 0.f, 0.f};
#pragma unroll
            for (int m = 0; m < 4; ++m) { const int row = row0 + ai * HALF + m * 16;
                const f32x4 bq = acc[ai][0][m][0], c = acc[ai][0][m][1], xi = acc[ai][1][m][0], z = acc[ai][1][m][1];
                const f32x4 uu = c * xi; f32x4 g, p15 = (f32x4){0.f, 0.f, 0.f, 0.f}, p14 = p15, y;
#pragma unroll
                for (int e = 0; e < 4; ++e) g[e] = bq[e] * z[e] * sigmoid_f(z[e]);
                if (m == 0) { const int bp = b > 0 ? b - 1 : 0; p14 = *(const PG8_LAS f32x4*)(xb + (bp * 2 + 0) * 64 + chl); p15 = *(const PG8_LAS f32x4*)(xb + (bp * 2 + 1) * 64 + chl); }
#pragma unroll
                for (int e = 0; e < 4; ++e) { float u1 = dpp_ror<1>(uu[e]), u2 = dpp_ror<2>(uu[e]);
                    if (m == 0) { u1 = fr == 0 ? p15[e] : u1; u2 = fr == 0 ? p14[e] : (fr == 1 ? p15[e] : u2); }
                    else { const float q1 = dpp_ror<1>(up[e]), q2 = dpp_ror<2>(up[e]); u1 = fr == 0 ? q1 : u1; u2 = fr < 2 ? q2 : u2; }
                    y[e] = g[e] * (w0[e] * u2 + w1[e] * u1 + w2[e] * uu[e]); }
                up = uu;
                if (b == 0 && m == 0 && fr < 2) { *(f32x4*)(HU + ((size_t)u.pm * 2 + fr) * 1024 + d0) = uu; *(f32x4*)(HG + ((size_t)u.pm * 2 + fr) * 1024 + d0) = g; }
                else { u32x2 wy; wy.x = cvt_pk_bf16(y[0], y[1]); wy.y = cvt_pk_bf16(y[2], y[3]); *(u32x2*)(Y + (size_t)row * 1024 + d0) = wy; } } }
    }
};
struct EpiConvOut {
    static constexpr bool PERM = true, AFTER_DRAIN = false;
    const bf16_t* XN; const float* RMS0; const float* G0; bf16_t* X1B; float* SSQ;
    __device__ __forceinline__ void operator()(const f32x4 (&acc)[2][2][4][2], const Unit& u, int wr, int wc, int fr, int fq) const {
        const int row0 = u.pm * BM + wr * 64 + fr, col0 = u.pn * BM + wc * 32 + 8 * fq;
        f32x4 gi[2][2];
#pragma unroll
        for (int bj = 0; bj < 2; ++bj)
#pragma unroll
            for (int n = 0; n < 2; ++n) { const f32x4 gg = *(const f32x4*)(G0 + col0 + bj * HALF + n * 4); gi[bj][n] = (f32x4){1.0f / gg[0], 1.0f / gg[1], 1.0f / gg[2], 1.0f / gg[3]}; }
#pragma unroll
        for (int ai = 0; ai < 2; ++ai)
#pragma unroll
            for (int m = 0; m < 4; ++m) { const int row = row0 + ai * HALF + m * 16; float s = 0.f; const float rms = RMS0[row];
#pragma unroll
                for (int bj = 0; bj < 2; ++bj) { const size_t off = (size_t)row * 1024 + col0 + bj * HALF;
                    const u32x4 xw = *(const u32x4*)(XN + off);
                    const f32x4 x0 = {__uint_as_float(xw.x << 16), __uint_as_float(xw.x & 0xffff0000u), __uint_as_float(xw.y << 16), __uint_as_float(xw.y & 0xffff0000u)};
                    const f32x4 x1 = {__uint_as_float(xw.z << 16), __uint_as_float(xw.z & 0xffff0000u), __uint_as_float(xw.w << 16), __uint_as_float(xw.w & 0xffff0000u)};
                    const f32x4 v0 = x0 * gi[bj][0] * rms + acc[ai][bj][m][0], v1 = x1 * gi[bj][1] * rms + acc[ai][bj][m][1];
                    s += ((v0[0] * v0[0] + v0[1] * v0[1]) + (v0[2] * v0[2] + v0[3] * v0[3])) + ((v1[0] * v1[0] + v1[1] * v1[1]) + (v1[2] * v1[2] + v1[3] * v1[3]));
                    u32x4 w; w.x = cvt_pk_bf16(v0[0], v0[1]); w.y = cvt_pk_bf16(v0[2], v0[3]); w.z = cvt_pk_bf16(v1[0], v1[1]); w.w = cvt_pk_bf16(v1[2], v1[3]); *(u32x4*)(X1B + off) = w; }
                s += __shfl_xor(s, 16); s += __shfl_xor(s, 32);
                if (fq == 0) SSQ[(size_t)row * 16 + u.pn * 4 + wc] = s; }
    }
};
struct EpiAttnIn {
    static constexpr bool PERM = true, AFTER_DRAIN = false;
    bf16_t* Q; bf16_t* K; bf16_t* V; bf16_t* SZ; const float* SSQ; const float* gq; const float* gk; float qscale;
    __device__ __forceinline__ void operator()(const f32x4 (&acc)[2][2][4][2], const Unit& u, int wr, int wc, int fr, int fq) const {
        const int kind = u.pn >> 2, hb = (u.pn & 3) * 4 + wc, row0 = u.pm * BM + wr * 64 + fr, col0 = hb * 64 + 8 * fq;
        bf16_t* base = kind == 0 ? Q : kind == 1 ? K : kind == 2 ? V : SZ;
        const float* g = kind == 0 ? gq : gk; const float post = kind == 0 ? qscale : 1.0f;
        f32x4 gv[2][2];
#pragma unroll
        for (int bj = 0; bj < 2; ++bj)
#pragma unroll
            for (int n = 0; n < 2; ++n) gv[bj][n] = *(const f32x4*)(g + 32 * bj + 8 * fq + 4 * n);
        float rsv[2][4];
#pragma unroll
        for (int ai = 0; ai < 2; ++ai)
#pragma unroll
            for (int m = 0; m < 4; ++m) { const f32x4 sa = *((const f32x4*)(SSQ + (size_t)(row0 + ai * HALF + m * 16) * 16) + fq); rsv[ai][m] = (sa[0] + sa[1]) + (sa[2] + sa[3]); }
#pragma unroll
        for (int ai = 0; ai < 2; ++ai)
#pragma unroll
            for (int m = 0; m < 4; ++m) { float ss = rsv[ai][m]; ss += __shfl_xor(ss, 16); ss += __shfl_xor(ss, 32); rsv[ai][m] = __builtin_amdgcn_rsqf(ss * (1.0f / 1024.0f) + 1e-6f); }
#pragma unroll
        for (int ai = 0; ai < 2; ++ai)
#pragma unroll
            for (int m = 0; m < 4; ++m) { const int row = row0 + ai * HALF + m * 16;
                const float rs = rsv[ai][m];
                f32x4 v[2][2];
#pragma unroll
                for (int bj = 0; bj < 2; ++bj)
#pragma unroll
                    for (int n = 0; n < 2; ++n) v[bj][n] = acc[ai][bj][m][n] * rs;
                if (kind < 2) { float hs = 0.f;
#pragma unroll
                    for (int bj = 0; bj < 2; ++bj)
#pragma unroll
                        for (int n = 0; n < 2; ++n) { const f32x4 x = v[bj][n]; hs += (x[0] * x[0] + x[1] * x[1]) + (x[2] * x[2] + x[3] * x[3]); }
                    hs += __shfl_xor(hs, 16); hs += __shfl_xor(hs, 32);
                    const float r = __builtin_amdgcn_rsqf(hs * (1.0f / 64.0f) + 1e-6f) * post;
#pragma unroll
                    for (int bj = 0; bj < 2; ++bj)
#pragma unroll
                        for (int n = 0; n < 2; ++n) v[bj][n] = v[bj][n] * r * gv[bj][n];
                } else if (kind == 3) {
#pragma unroll
                    for (int bj = 0; bj < 2; ++bj)
#pragma unroll
                        for (int n = 0; n < 2; ++n)
#pragma unroll
                            for (int e = 0; e < 4; ++e) v[bj][n][e] = v[bj][n][e] * sigmoid_f(v[bj][n][e]);
                }
#pragma unroll
                for (int bj = 0; bj < 2; ++bj) { u32x4 w; w.x = cvt_pk_bf16(v[bj][0][0], v[bj][0][1]); w.y = cvt_pk_bf16(v[bj][0][2], v[bj][0][3]); w.z = cvt_pk_bf16(v[bj][1][0], v[bj][1][1]); w.w = cvt_pk_bf16(v[bj][1][2], v[bj][1][3]);
                    const size_t off = (kind == 1 || kind == 2) ? ((size_t)hb * 16384 + row) * 64 + 8 * fq + 32 * bj
                                                                 : (size_t)row * 1024 + col0 + 32 * bj;
                    *(u32x4*)(base + off) = w; } }
    }
};
struct EpiOut {
    static constexpr bool PERM = true, AFTER_DRAIN = false;
    const bf16_t* X1B; float* OUT;
    __device__ __forceinline__ void operator()(const f32x4 (&acc)[2][2][4][2], const Unit& u, int wr, int wc, int fr, int fq) const {
        const int row0 = u.pm * BM + wr * 64 + fr, col0 = u.pn * BM + wc * 32 + 8 * fq;
#pragma unroll
        for (int ai = 0; ai < 2; ++ai)
#pragma unroll
            for (int m = 0; m < 4; ++m)
#pragma unroll
                for (int bj = 0; bj < 2; ++bj) { const size_t off = (size_t)(row0 + ai * HALF + m * 16) * 1024 + col0 + bj * HALF; const u32x4 w = *(const u32x4*)(X1B + off);
                    const f32x4 b0 = {__uint_as_float(w.x << 16), __uint_as_float(w.x & 0xffff0000u), __uint_as_float(w.y << 16), __uint_as_float(w.y & 0xffff0000u)};
                    const f32x4 b1 = {__uint_as_float(w.z << 16), __uint_as_float(w.z & 0xffff0000u), __uint_as_float(w.w << 16), __uint_as_float(w.w & 0xffff0000u)};
                    __builtin_nontemporal_store(b0 + acc[ai][bj][m][0], (f32x4*)(OUT + off)); __builtin_nontemporal_store(b1 + acc[ai][bj][m][1], (f32x4*)(OUT + off + 4)); }
    }
};

template <class Epi, class Sched, bool ALIGN_EPI = false, bool SP2 = false>
__device__ __forceinline__ void gemm_phase(PG8_LAS unsigned char* lds, const Gemm g, const Sched& S, const Epi& E) {
    int tid_ = threadIdx.x; asm volatile("" : "+v"(tid_));
    const int tid = tid_, wid = __builtin_amdgcn_readfirstlane(tid >> 6), lane = tid & 63, wr = wid >> 2, wc = wid & 3, fr = lane & 15, fq = lane >> 4;
    const int K = g.K, nt = K / BK;
    unsigned voffA[2], voffB[2];
#pragma unroll
    for (int i = 0; i < 2; ++i) { int R, C; stage_rc(tid * 16 + i * 8192, R, C); const int Rb = Epi::PERM ? ((R & ~31) + perm32(R & 31)) : R;
        voffA[i] = (unsigned)(R * K + C) * 2u; voffB[i] = (unsigned)(Rb * K + C) * 2u; }
    const size_t kstep = (size_t)(BK * 2);
    const size_t hstep = (size_t)HALF * K * 2;
    const size_t tstep = 2 * hstep;
    const unsigned ldsw = (unsigned)wid * 1024u;
    const int aoff = lds_byte(wr * 64 + fr, fq * 8), boff = lds_byte(wc * 32 + fr, fq * 8);
#define PG8_SA(b, h) (((b) * 2 + (h)) * HTB)
#define PG8_SB(b, h) ((4 + (b) * 2 + (h)) * HTB)
#define PG8_STAGE(bufoff, gbase, voff) do { _Pragma("unroll") for (int _i = 0; _i < 2; ++_i) \
        __builtin_amdgcn_global_load_lds((const unsigned*)((const char*)(gbase) + (voff)[_i]), (PG8_LAS unsigned*)(lds + (bufoff) + ldsw + _i * 8192), 16, 0, 0); } while (0)
#define PG8_LDA(dst, b, h) do { _Pragma("unroll") for (int m = 0; m < 4; ++m) _Pragma("unroll") for (int k = 0; k < 2; ++k) dst[m][k] = *(const PG8_LAS bf16x8*)(lds + PG8_SA(b, h) + aoff + m * 2048 + k * 1024); } while (0)
#define PG8_LDB(dst, b, h) do { _Pragma("unroll") for (int n = 0; n < 2; ++n) _Pragma("unroll") for (int k = 0; k < 2; ++k) dst[n][k] = *(const PG8_LAS bf16x8*)(lds + PG8_SB(b, h) + boff + n * 2048 + k * 1024); } while (0)
#define PG8_MMA(ai, bj, At, Bt) do { __builtin_amdgcn_s_setprio(1); _Pragma("unroll") for (int m = 0; m < 4; ++m) _Pragma("unroll") for (int n = 0; n < 2; ++n) _Pragma("unroll") for (int k = 0; k < 2; ++k) \
        acc[ai][bj][m][n] = __builtin_amdgcn_mfma_f32_16x16x32_bf16(Bt[n][k], At[m][k], acc[ai][bj][m][n], 0, 0, 0); __builtin_amdgcn_s_setprio(0); } while (0)
#define PG8_WAIT_V(n) asm volatile("s_waitcnt vmcnt(" #n ")" ::: "memory")
#define PG8_WAIT_L(n) asm volatile("s_waitcnt lgkmcnt(" #n ")" ::: "memory")
#define PG8_BAR __builtin_amdgcn_s_barrier()
#define PG8_SCHED __builtin_amdgcn_sched_barrier(0)
    Unit cur, nxt; int ui = 0;
    if (!S.next(0, cur)) return;
    f32x4 acc[2][2][4][2];
#pragma unroll
    for (int a = 0; a < 2; ++a)
#pragma unroll
        for (int b = 0; b < 2; ++b)
#pragma unroll
            for (int m = 0; m < 4; ++m)
#pragma unroll
                for (int n = 0; n < 2; ++n) acc[a][b][m][n] = (f32x4){0.f, 0.f, 0.f, 0.f};
    bf16x8 At[4][2], B0[2][2], B1[2][2];
    const char* cA = (const char*)g.A + (size_t)cur.pm * tstep; const char* cB = (const char*)g.Bt + (size_t)cur.pn * tstep;
    S.a_ready(cur);
    if constexpr (SP2) {
        PG8_STAGE(PG8_SB(0, 0), cB, voffB); PG8_STAGE(PG8_SB(0, 1), cB + hstep, voffB); PG8_STAGE(PG8_SA(0, 0), cA, voffA); PG8_STAGE(PG8_SA(0, 1), cA + hstep, voffA);
        if (wr == 1) PG8_BAR;
        PG8_WAIT_V(2); PG8_BAR;
        PG8_STAGE(PG8_SB(1, 0), cB + kstep, voffB); PG8_STAGE(PG8_SA(1, 0), cA + kstep, voffA); PG8_STAGE(PG8_SB(1, 1), cB + hstep + kstep, voffB);
        PG8_WAIT_V(6); PG8_BAR;
    } else {
        PG8_STAGE(PG8_SB(0, 0), cB, voffB); PG8_STAGE(PG8_SA(0, 0), cA, voffA); PG8_STAGE(PG8_SB(0, 1), cB + hstep, voffB); PG8_STAGE(PG8_SA(0, 1), cA + hstep, voffA);
        if (wr == 1) PG8_BAR;
        PG8_WAIT_V(4); PG8_BAR;
        PG8_STAGE(PG8_SB(1, 0), cB + kstep, voffB); PG8_STAGE(PG8_SA(1, 0), cA + kstep, voffA); PG8_STAGE(PG8_SB(1, 1), cB + hstep + kstep, voffB);
        PG8_WAIT_V(6); PG8_BAR;
    }
    for (;;) {
        const bool has_next = S.next(ui + 1, nxt);
        const char* nA = has_next ? (const char*)g.A + (size_t)nxt.pm * tstep : cA; const char* nB = has_next ? (const char*)g.Bt + (size_t)nxt.pn * tstep : cB;
        for (int t = 0; t < nt; t += 2) {
            const bool last = (t == nt - 2);
            const char* a1 = cA + (size_t)(t + 1) * kstep;
            const char* a2 = last ? nA : cA + (size_t)(t + 2) * kstep; const char* b2 = last ? nB : cB + (size_t)(t + 2) * kstep;
            const char* a3 = a2 + kstep; const char* b3 = b2 + kstep;
            if (last && has_next) S.a_ready(nxt);
            if constexpr (SP2) {
            PG8_LDB(B0, 0, 0); PG8_LDB(B1, 0, 1); PG8_SCHED; PG8_LDA(At, 0, 0); PG8_STAGE(PG8_SA(1, 1), a1 + hstep, voffA);
            PG8_WAIT_V(8); PG8_WAIT_L(0); PG8_BAR; PG8_MMA(0, 0, At, B0); PG8_MMA(0, 1, At, B1); PG8_BAR; PG8_SCHED;
            PG8_LDA(At, 0, 1); PG8_STAGE(PG8_SB(0, 0), b2, voffB); PG8_STAGE(PG8_SB(0, 1), b2 + hstep, voffB); PG8_STAGE(PG8_SA(0, 0), a2, voffA);
            PG8_WAIT_V(8); PG8_WAIT_L(0); PG8_BAR; PG8_MMA(1, 0, At, B0); PG8_MMA(1, 1, At, B1); PG8_BAR; PG8_SCHED;
            PG8_LDB(B0, 1, 0); PG8_LDB(B1, 1, 1); PG8_SCHED; PG8_LDA(At, 1, 0); PG8_STAGE(PG8_SA(0, 1), a2 + hstep, voffA);
            PG8_WAIT_V(8); PG8_WAIT_L(0); PG8_BAR; PG8_MMA(0, 0, At, B0); PG8_MMA(0, 1, At, B1); PG8_BAR; PG8_SCHED;
            PG8_LDA(At, 1, 1); PG8_STAGE(PG8_SB(1, 0), b3, voffB); PG8_STAGE(PG8_SB(1, 1), b3 + hstep, voffB); PG8_STAGE(PG8_SA(1, 0), a3, voffA);
            PG8_WAIT_V(8); PG8_WAIT_L(0); PG8_BAR; PG8_MMA(1, 0, At, B0); PG8_MMA(1, 1, At, B1); PG8_BAR; PG8_SCHED;
            } else {
            PG8_LDB(B0, 0, 0); PG8_SCHED; PG8_LDA(At, 0, 0); PG8_STAGE(PG8_SA(1, 1), a1 + hstep, voffA);
            PG8_WAIT_L(8); PG8_BAR; PG8_WAIT_L(0); PG8_MMA(0, 0, At, B0); PG8_BAR; PG8_SCHED;
            PG8_LDB(B1, 0, 1); PG8_STAGE(PG8_SB(0, 0), b2, voffB);
            PG8_BAR; PG8_WAIT_L(0); PG8_MMA(0, 1, At, B1); PG8_BAR;
            PG8_LDA(At, 0, 1); PG8_STAGE(PG8_SA(0, 0), a2, voffA);
            PG8_BAR; PG8_WAIT_L(0); PG8_MMA(1, 0, At, B0); PG8_BAR; PG8_SCHED;
            PG8_STAGE(PG8_SB(0, 1), b2 + hstep, voffB);
            PG8_WAIT_V(6); PG8_BAR; PG8_MMA(1, 1, At, B1); PG8_BAR;
            PG8_LDB(B0, 1, 0); PG8_SCHED; PG8_LDA(At, 1, 0); PG8_STAGE(PG8_SA(0, 1), a2 + hstep, voffA);
            PG8_WAIT_L(8); PG8_BAR; PG8_WAIT_L(0); PG8_MMA(0, 0, At, B0); PG8_BAR; PG8_SCHED;
            PG8_LDB(B1, 1, 1); PG8_STAGE(PG8_SB(1, 0), b3, voffB);
            PG8_BAR; PG8_WAIT_L(0); PG8_MMA(0, 1, At, B1); PG8_BAR;
            PG8_LDA(At, 1, 1); PG8_STAGE(PG8_SA(1, 0), a3, voffA);
            PG8_BAR; PG8_WAIT_L(0); PG8_MMA(1, 0, At, B0); PG8_BAR; PG8_SCHED;
            PG8_STAGE(PG8_SB(1, 1), b3 + hstep, voffB);
            PG8_WAIT_V(6); PG8_BAR; PG8_MMA(1, 1, At, B1); PG8_BAR;
            }
        }
        if constexpr (ALIGN_EPI) { if (wr == 0) PG8_BAR; }
        if constexpr (!Epi::AFTER_DRAIN) { E(acc, cur, wr, wc, fr, fq); S.done(cur); }
        if (!has_next) break;
#pragma unroll
        for (int a = 0; a < 2; ++a)
#pragma unroll
            for (int b = 0; b < 2; ++b)
#pragma unroll
                for (int m = 0; m < 4; ++m)
#pragma unroll
                    for (int n = 0; n < 2; ++n) acc[a][b][m][n] = (f32x4){0.f, 0.f, 0.f, 0.f};
        cur = nxt; cA = nA; cB = nB; ++ui;
        if constexpr (ALIGN_EPI) { if (wr == 1) PG8_BAR; }
    }
    PG8_WAIT_V(0);
    if constexpr (!ALIGN_EPI) { if (wr == 0) PG8_BAR; }
    PG8_BAR;
    if constexpr (Epi::AFTER_DRAIN) { E.fused(acc, cur, wr, wc, fr, fq, lds, wid, lane); S.done(cur); }
#undef PG8_SA
#undef PG8_SB
#undef PG8_STAGE
#undef PG8_LDA
#undef PG8_LDB
#undef PG8_MMA
#undef PG8_WAIT_V
#undef PG8_WAIT_L
#undef PG8_BAR
#undef PG8_SCHED
}
}
#include <hip/hip_bf16.h>
#include <cmath>
namespace attn_body {
using bf16=__hip_bfloat16;
using bf16x8=__attribute__((ext_vector_type(8)))short;
using s16x4=__attribute__((ext_vector_type(4)))short;
using f32x16=__attribute__((ext_vector_type(16)))float;
using u32x4=__attribute__((ext_vector_type(4)))unsigned;
constexpr int BATCH=1,NHEAD=16,SEQ=16384,D=64,DM=NHEAD*D;
constexpr int NW=8,QBLK=32,QB=QBLK*NW,KVBLK=64,NQB=SEQ/QB;
constexpr int ATTN_PITCH=DM, ATTN_UNIT_ROWS=QB, NUNITS=NHEAD*NQB;
typedef __attribute__((address_space(3))) const char* lds_cptr;
__device__ __forceinline__ int crow(int r,int hi){return (r&3)+8*(r>>2)+4*hi;}
#define SBAR() __builtin_amdgcn_sched_barrier(0)
__device__ __forceinline__ void cmask(f32x16&p0,f32x16&p1,int jb,int qrel,int hi){
  const float NEG=-INFINITY; int kb=64*jb+4*hi;
  #pragma unroll
  for(int r=0;r<16;++r){int kv=kb+(r&3)+8*(r>>2); if(kv>qrel)p0[r]=NEG; if(kv+32>qrel)p1[r]=NEG;}
}

constexpr int NSLOT=3, SLOTB=8192;
constexpr int LDS_K=0, LDS_V=NSLOT*SLOTB, LDS_WS=2*NSLOT*SLOTB, LDS_OST=LDS_WS+NW*64*4, LDS_BYTES=LDS_OST+NW*4096, LDS_C2=LDS_BYTES, LDS_RT=LDS_C2+SEQ*4, LDS_ALL=LDS_RT+8192+64;
constexpr float C2=0.125f*1.4426950408889634f;
__device__ __forceinline__ void glds16(const void*gsrc,unsigned lds_dst){unsigned keep;
  asm volatile("s_mov_b32 %0, m0\n\ts_mov_b32 m0, %2\n\ts_nop 0\n\tglobal_load_lds_dwordx4 %1, off\n\ts_mov_b32 m0, %0":"=&s"(keep):"v"(gsrc),"s"(lds_dst):"memory");}
__device__ __forceinline__ float max3f(float a,float b,float c){float r;asm("v_max3_f32 %0, %1, %2, %3":"=v"(r):"v"(a),"v"(b),"v"(c));return r;}
__device__ __forceinline__ float max2f(float a,float b){float r;asm("v_max_f32_e32 %0, %1, %2":"=v"(r):"v"(a),"v"(b));return r;}
__device__ __forceinline__ float fadd_s(float a,float b){float r;asm("v_add_f32_e32 %0, %1, %2":"=v"(r):"v"(a),"v"(b));return r;}
__device__ __forceinline__ float fsub_s(float a,float b){float r;asm("v_sub_f32_e32 %0, %1, %2":"=v"(r):"v"(a),"v"(b));return r;}
typedef float f32x2_t __attribute__((ext_vector_type(2))); typedef __bf16 bf16x2_t __attribute__((ext_vector_type(2)));
__device__ __forceinline__ unsigned cvtpk_s(float lo,float hi){f32x2_t v={lo,hi};bf16x2_t b=__builtin_convertvector(v,bf16x2_t);return __builtin_bit_cast(unsigned,b);}
#define WAIT_BAR(N) asm volatile("s_waitcnt vmcnt(" #N ") lgkmcnt(0)\n\ts_barrier":::"memory")

__device__ __forceinline__ void qkt(f32x16&p0,f32x16&p1,const char*Kslot,const bf16x8*qr,const f32x16&negm,int r32,int hi){
  const char*kb=Kslot+hi*1024+r32*16;
  #pragma unroll
  for(int d0=0;d0<4;++d0){
    const bf16x8 b0=*reinterpret_cast<const bf16x8*>(kb+d0*2048);
    const bf16x8 b1=*reinterpret_cast<const bf16x8*>(kb+d0*2048+512);
    if(d0==0){p0=__builtin_amdgcn_mfma_f32_32x32x16_bf16(b0,qr[0],negm,0,0,0);p1=__builtin_amdgcn_mfma_f32_32x32x16_bf16(b1,qr[0],negm,0,0,0);}
    else{p0=__builtin_amdgcn_mfma_f32_32x32x16_bf16(b0,qr[d0],p0,0,0,0);p1=__builtin_amdgcn_mfma_f32_32x32x16_bf16(b1,qr[d0],p1,0,0,0);}}
}
typedef short v4i16_t __attribute__((ext_vector_type(4)));
__device__ __forceinline__ void kload8(bf16x8*kf,lds_cptr kp){
  kf[0]=*(const __attribute__((address_space(3))) bf16x8*)(kp);      kf[1]=*(const __attribute__((address_space(3))) bf16x8*)(kp+512);
  kf[2]=*(const __attribute__((address_space(3))) bf16x8*)(kp+2048); kf[3]=*(const __attribute__((address_space(3))) bf16x8*)(kp+2560);
  kf[4]=*(const __attribute__((address_space(3))) bf16x8*)(kp+4096); kf[5]=*(const __attribute__((address_space(3))) bf16x8*)(kp+4608);
  kf[6]=*(const __attribute__((address_space(3))) bf16x8*)(kp+6144); kf[7]=*(const __attribute__((address_space(3))) bf16x8*)(kp+6656);
}
__device__ __forceinline__ void kload2(bf16x8*kf,lds_cptr kp,int j){ kf[2*j]=*(const __attribute__((address_space(3))) bf16x8*)(kp+j*2048); kf[2*j+1]=*(const __attribute__((address_space(3))) bf16x8*)(kp+j*2048+512); }
__device__ __forceinline__ s16x4 vtr(lds_cptr p){ return __builtin_bit_cast(s16x4,__builtin_amdgcn_ds_read_tr16_b64_v4i16((__attribute__((address_space(3))) v4i16_t*)p)); }
__device__ __forceinline__ float rowmax(const f32x16&p0,const f32x16&p1){
  float a=max3f(p0[0],p0[1],p1[0]),b=max3f(p0[2],p0[3],p1[1]);a=max3f(a,p1[2],p1[3]);
  #pragma unroll
  for(int r=4;r<16;r+=4){a=max3f(a,p0[r],p0[r+1]);b=max3f(b,p0[r+2],p0[r+3]);a=max3f(a,p1[r],p1[r+1]);b=max3f(b,p1[r+2],p1[r+3]);}
  const float m=max2f(a,b);
  auto rr=__builtin_amdgcn_permlane32_swap(__float_as_uint(m),__float_as_uint(m),false,false);
  return max2f(__uint_as_float(rr[0]),__uint_as_float(rr[1]));
}
__device__ __forceinline__ void pv(f32x16*o,int vb,bf16x8 pa0,bf16x8 pa1,bf16x8 pa2,bf16x8 pa3){
  #pragma unroll
  for(int d0=0;d0<2;++d0){s16x4 lo[4],hi[4];
    #pragma unroll
    for(int ks=0;ks<4;++ks){
      asm volatile("ds_read_b64_tr_b16 %0,%1 offset:%c2":"=&v"(lo[ks]):"v"(vb),"i"(d0*4096+ks*1024):"memory");
      asm volatile("ds_read_b64_tr_b16 %0,%1 offset:%c2":"=&v"(hi[ks]):"v"(vb),"i"(d0*4096+ks*1024+512):"memory");}
    asm volatile("s_waitcnt lgkmcnt(0)":::"memory");SBAR();
    #define PK(k) (bf16x8){lo[k][0],lo[k][1],lo[k][2],lo[k][3],hi[k][0],hi[k][1],hi[k][2],hi[k][3]}
    o[d0]=__builtin_amdgcn_mfma_f32_32x32x16_bf16(pa0,PK(0),o[d0],0,0,0);
    o[d0]=__builtin_amdgcn_mfma_f32_32x32x16_bf16(pa1,PK(1),o[d0],0,0,0);
    o[d0]=__builtin_amdgcn_mfma_f32_32x32x16_bf16(pa2,PK(2),o[d0],0,0,0);
    o[d0]=__builtin_amdgcn_mfma_f32_32x32x16_bf16(pa3,PK(3),o[d0],0,0,0);
    #undef PK
  }
}

#ifndef ATTN_STORE16
#define ATTN_STORE16(p,v) (*(u32x4*)(p)=(v))
#endif
typedef float f32x4v __attribute__((ext_vector_type(4)));
__device__ __forceinline__ void attn_tables(int h,int qb,const float*__restrict__ TOT,float negTH,int ui,char*shm,int lane){
  typedef __attribute__((address_space(3))) float lds_f; typedef __attribute__((address_space(3))) int lds_i;
  const lds_cptr shmL=(lds_cptr)shm; lds_f* rtab=(lds_f*)(shmL+LDS_RT)+ui*256; lds_i* tsw=(lds_i*)(shmL+LDS_RT+8192);
  const int j0=4*qb; const float* tp=TOT+h*(SEQ/KVBLK); const int base=j0-1-4*lane;
  const float v0=base>=0?tp[base>=0?base:0]:0.f, v1=base-1>=0?tp[base-1>=0?base-1:0]:0.f, v2=base-2>=0?tp[base-2>=0?base-2:0]:0.f, v3=base-3>=0?tp[base-3>=0?base-3:0]:0.f;
  const float s0=v0,s1=s0+v1,s2=s1+v2,s3=s2+v3; float inc=s3;
  _Pragma("unroll") for(int o=1;o<64;o<<=1){const float y=__shfl_up(inc,o); if(lane>=o)inc+=y;}
  const float off=inc-s3; const float S0=off+s0,S1=off+s1,S2=off+s2,S3=off+s3;
  int cnt=((base>=0&&(S0-v0)>=negTH)?1:0)+((base-1>=0&&(S1-v1)>=negTH)?1:0)+((base-2>=0&&(S2-v2)>=negTH)?1:0)+((base-3>=0&&(S3-v3)>=negTH)?1:0);
  _Pragma("unroll") for(int o=1;o<64;o<<=1)cnt+=__shfl_xor(cnt,o);
  if(base>=0)rtab[base]=-S0; if(base-1>=0)rtab[base-1]=-S1; if(base-2>=0)rtab[base-2]=-S2; if(base-3>=0)rtab[base-3]=-S3;
  if(lane==0){const float a=tp[j0],b2=tp[j0+1],c=tp[j0+2]; rtab[j0]=0.f; rtab[j0+1]=a; rtab[j0+2]=a+b2; rtab[j0+3]=a+b2+c; tsw[ui]=(j0-cnt)&~1;}
}
__device__ __forceinline__ void attn_tables_fin(int qb,float v0,float v1,float v2,float v3,float a,float b2,float c,float negTH,int ui,char*shm,int lane){
  typedef __attribute__((address_space(3))) float lds_f; typedef __attribute__((address_space(3))) int lds_i;
  const lds_cptr shmL=(lds_cptr)shm; lds_f* rtab=(lds_f*)(shmL+LDS_RT)+ui*256; lds_i* tsw=(lds_i*)(shmL+LDS_RT+8192);
  const int j0=4*qb; const int base=j0-1-4*lane;
  const float s0=v0,s1=s0+v1,s2=s1+v2,s3=s2+v3; float inc=s3;
  _Pragma("unroll") for(int o=1;o<64;o<<=1){const float y=__shfl_up(inc,o); if(lane>=o)inc+=y;}
  const float off=inc-s3; const float S0=off+s0,S1=off+s1,S2=off+s2,S3=off+s3;
  int cnt=((base>=0&&(S0-v0)>=negTH)?1:0)+((base-1>=0&&(S1-v1)>=negTH)?1:0)+((base-2>=0&&(S2-v2)>=negTH)?1:0)+((base-3>=0&&(S3-v3)>=negTH)?1:0);
  _Pragma("unroll") for(int o=1;o<64;o<<=1)cnt+=__shfl_xor(cnt,o);
  if(base>=0)rtab[base]=-S0; if(base-1>=0)rtab[base-1]=-S1; if(base-2>=0)rtab[base-2]=-S2; if(base-3>=0)rtab[base-3]=-S3;
  if(lane==0){ rtab[j0]=0.f; rtab[j0+1]=a; rtab[j0+2]=a+b2; rtab[j0+3]=a+b2+c; tsw[ui]=(j0-cnt)&~1;}
}
__device__ __forceinline__ float bflo(unsigned w){return __uint_as_float(w<<16);} __device__ __forceinline__ float bfhi(unsigned w){return __uint_as_float(w&0xffff0000u);}
template<int THRL> __device__ __forceinline__ void attn_unit(int h,int qb,const bf16*Q,const bf16*__restrict__ K,const bf16*__restrict__ V,const bf16*__restrict__ SZ,bf16*O,const float*__restrict__ CL,int ui,unsigned*ctr,const float*__restrict__ TOT,float negTH,const __attribute__((address_space(3))) int*hor,char*shm){
  int tid_=threadIdx.x; asm volatile("":"+v"(tid_)); const int tid=tid_,lane=tid&63,r32=lane&31,hi=lane>>5; const int wid=__builtin_amdgcn_readfirstlane(tid>>6);
  const int q0=qb*QB;
  typedef __attribute__((address_space(3))) float lds_f; typedef __attribute__((address_space(3))) int lds_i;
  const lds_cptr shmL=(lds_cptr)shm;
  lds_f* c2l=(lds_f*)(shmL+LDS_C2); const lds_f* rtab=(const lds_f*)(shmL+LDS_RT)+ui*256; const lds_i* tsw=(const lds_i*)(shmL+LDS_RT+8192);
  const int ts=__builtin_amdgcn_readfirstlane(tsw[ui]);
  const lds_cptr c2p=shmL+LDS_C2+hi*16;
  const long rowbase=0;
  const bf16*Qw=Q+(long)(q0+wid*QBLK)*DM+h*D;
  const bf16*Kh=K+((long)h*SEQ+(long)ts*KVBLK)*D,*Vh=V+((long)h*SEQ+(long)ts*KVBLK)*D;
  #define INITLD(P0,P1,t) do{ const __attribute__((address_space(3))) f32x4v* cp_=(const __attribute__((address_space(3))) f32x4v*)(c2p+(t)*256); \
    _Pragma("unroll") for(int g_=0;g_<4;++g_){ const f32x4v a_=cp_[2*g_], b_=cp_[8+2*g_]; \
      P0[4*g_]=a_[0];P0[4*g_+1]=a_[1];P0[4*g_+2]=a_[2];P0[4*g_+3]=a_[3]; P1[4*g_]=b_[0];P1[4*g_+1]=b_[1];P1[4*g_+2]=b_[2];P1[4*g_+3]=b_[3]; } }while(0)
  #define INITSUB(P0,P1) do{ const float nm_=-mhat; _Pragma("unroll") for(int r=0;r<16;++r){P0[r]=nm_-P0[r];P1[r]=nm_-P1[r];} }while(0)
  #define CBIAS(P0,P1,t) do{ const __attribute__((address_space(3))) f32x4v* cp_=(const __attribute__((address_space(3))) f32x4v*)(c2p+(t)*256); \
    _Pragma("unroll") for(int g_=0;g_<4;++g_){ const f32x4v a_=cp_[2*g_], b_=cp_[8+2*g_]; \
      P0[4*g_]-=a_[0];P0[4*g_+1]-=a_[1];P0[4*g_+2]-=a_[2];P0[4*g_+3]-=a_[3]; P1[4*g_]-=b_[0];P1[4*g_+1]-=b_[1];P1[4*g_+2]-=b_[2];P1[4*g_+3]-=b_[3]; SBAR(); } }while(0)
  const unsigned lds0=(unsigned)(uintptr_t)shm;
  float*wsf=(float*)(shm+LDS_WS)+wid*64;
  const bf16*ksrc=Kh+(long)lane*D+wid*8;
  const bf16*vsrc=Vh+(long)(16*(wid&3)+(lane>>2))*D+(wid>>2)*32+(lane&3)*8;
  const unsigned kdst=lds0+LDS_K+wid*1024, vdst=lds0+LDS_V+wid*1024;
  #define DMA_K(t,slot) glds16(ksrc+(long)(t)*KVBLK*D,(unsigned)__builtin_amdgcn_readfirstlane(kdst+(slot)))
  #define DMA_V(t,slot) glds16(vsrc+(long)(t)*KVBLK*D,(unsigned)__builtin_amdgcn_readfirstlane(vdst+(slot)))
  const int vb0=(int)(lds0+LDS_V)+((lane>>4)&1)*32+(lane&3)*8+(4*hi+((lane&15)>>2))*64;
  const char*Kbase=shm+LDS_K; bf16x8 kf[8];
  const lds_cptr shm3=(lds_cptr)shm; const lds_cptr kp0=shm3+LDS_K+hi*1024+r32*16; const lds_cptr vp0=shm3+LDS_V+((lane>>4)&1)*32+(lane&3)*8+(4*hi+((lane&15)>>2))*64;
  const int NT=(q0+QB)/KVBLK-ts;
  DMA_K(0,0);DMA_V(0,0);DMA_K(1,SLOTB);
  bf16x8 qr[4];
  #pragma unroll
  for(int d0=0;d0<4;++d0)qr[d0]=*reinterpret_cast<const bf16x8*>(&Qw[(long)r32*DM+d0*16+hi*8]);
  float mhat=0.f,l_reg=0.f;f32x16 o[2];o[0]=f32x16{};o[1]=f32x16{};const f32x16 zero16=f32x16{};
  const int qrel=wid*QBLK+r32;
  #define CMASK(P0,P1,t) do{int jb_=(t)-(NT-4); if(jb_>=0)cmask(P0,P1,jb_,qrel,hi);}while(0)
  bool resc=false;
  #define START(P0,P1) do{ const float rm=rowmax(P0,P1); resc=false; \
    { const float dl=rm; mhat=fadd_s(mhat,dl); \
      _Pragma("unroll") for(int r=0;r<16;++r){P0[r]=fsub_s(P0[r],dl);P1[r]=fsub_s(P1[r],dl);} \
      } \
    _Pragma("unroll") for(int r=0;r<16;++r)P0[r]=__builtin_amdgcn_exp2f(P0[r]); }while(0)
  #define RESC() do{ if(resc){ asm volatile("s_waitcnt lgkmcnt(0)":::"memory"); \
      _Pragma("unroll") for(int d_=0;d_<2;++d_) _Pragma("unroll") for(int r=0;r<16;++r)o[d_][r]*=wsf[crow(r,hi)]; } }while(0)
  f32x16 pA0,pA1,pB0,pB1;
  int sl_prev=0,sl_cur=0,sl_next=SLOTB;
  #define ROT() do{sl_prev=sl_cur;sl_cur=sl_next;sl_next=(sl_next==(NSLOT-1)*SLOTB)?0:sl_next+SLOTB;}while(0)
  DMA_K(2,2*SLOTB);
  { const float* clp=CL+(long)h*SEQ+ts*KVBLK; const int n=(q0+QB)-ts*KVBLK;
    for(int i0=tid;i0<n;i0+=4*NW*64){ float cv[4];
      _Pragma("unroll") for(int j=0;j<4;++j){ const int i=i0+j*NW*64; cv[j]=clp[i<n?i:0]; }
      _Pragma("unroll") for(int j=0;j<4;++j){ const int i=i0+j*NW*64; if(i<n) c2l[i]=(cv[j]+rtab[(ts*KVBLK+i)>>6])*1.4426950408889634f; } } }
  unsigned nraw=0u; if(wid==0&&lane==0)nraw=__hip_atomic_fetch_add(ctr,1u,__ATOMIC_RELAXED,__HIP_MEMORY_SCOPE_AGENT);
  WAIT_BAR(3);
  qkt(pA0,pA1,Kbase,qr,zero16,r32,hi);asm volatile("s_nop 15\n\ts_nop 7":"+v"(pA0),"+v"(pA1));CBIAS(pA0,pA1,0);CMASK(pA0,pA1,0);
  START(pA0,pA1);
  _Pragma("unroll") for(int r=0;r<16;++r)pA1[r]=__builtin_amdgcn_exp2f(pA1[r]);
  INITLD(pB0,pB1,1); INITSUB(pB0,pB1);
  WAIT_BAR(0);
  DMA_K(3,0);DMA_V(1,SLOTB);
  ROT();
  kload8(kf,kp0+sl_cur);
  WAIT_BAR(2);
  s16x4 vlo[8],vhi[8]; u32x4 pw0,pw1,pw2,pw3;
  #define PKW(P,B) cvtpk_s(P[B],P[B+1])
  #define PAF(k) __builtin_bit_cast(bf16x8,pw##k)
  #define VFR(i) (bf16x8){vlo[i][0],vlo[i][1],vlo[i][2],vlo[i][3],vhi[i][0],vhi[i][1],vhi[i][2],vhi[i][3]}
  #define PIN(x) asm volatile("":"+v"(x))
  #define MX3(a,b,c) __builtin_fmaxf(__builtin_fmaxf((a),(b)),(c))
  #define GAPA(MF,A0,A1,A2,A3,W0,W1,PW) do{ MF; sacc+=A0; sacc+=A1; sacc+=A2; sacc+=A3; PIN(sacc); W0; W1; PIN(PW); SBAR(); }while(0)
  #define EX(v) __builtin_amdgcn_exp2f(v)
  #define GAPB(MF,X,B) do{ MF; X[B]=EX(X[B]); X[B+1]=EX(X[B+1]); X[B+2]=EX(X[B+2]); X[B+3]=EX(X[B+3]); PIN(X); SBAR(); }while(0)
  #define VRD(i) do{ vlo[i]=vtr(vp_+(((i)>>2)*4096+((i)&3)*1024)); vhi[i]=vtr(vp_+(((i)>>2)*4096+((i)&3)*1024+512)); }while(0)
  #define KRD(G,j) do{ if(G){ kload2(kf,kp0+sl_next,j); SBAR(); } }while(0)
  #define STEP(C0,C1,P0,P1,t,GK,GV,GL,ZL) do{ SBAR(); \
    const lds_cptr vp_=vp0+sl_prev; \
    VRD(0); SBAR(); float sacc=(P0[0]+P0[1]); \
    GAPA(C0=__builtin_amdgcn_mfma_f32_32x32x16_bf16(kf[0],qr[0],C0,0,0,0), P0[2],P0[3],P0[4],P0[5],     pw0[0]=PKW(P0,0), pw0[1]=PKW(P0,2), pw0); \
    VRD(4); SBAR(); GAPA(C1=__builtin_amdgcn_mfma_f32_32x32x16_bf16(kf[1],qr[0],C1,0,0,0), P0[6],P0[7],P0[8],P0[9],     pw0[2]=PKW(P0,4), pw0[3]=PKW(P0,6), pw0); \
    VRD(1); SBAR(); GAPA(C0=__builtin_amdgcn_mfma_f32_32x32x16_bf16(kf[2],qr[1],C0,0,0,0),   P0[10],P0[11],P0[12],P0[13], pw1[0]=PKW(P0,8), pw1[1]=PKW(P0,10), pw1); \
    VRD(5); SBAR(); GAPA(C1=__builtin_amdgcn_mfma_f32_32x32x16_bf16(kf[3],qr[1],C1,0,0,0),   P0[14],P0[15],P1[0],P1[1],   pw1[2]=PKW(P0,12),pw1[3]=PKW(P0,14), pw1); \
    VRD(2); SBAR(); GAPA(C0=__builtin_amdgcn_mfma_f32_32x32x16_bf16(kf[4],qr[2],C0,0,0,0),   P1[2],P1[3],P1[4],P1[5],     pw2[0]=PKW(P1,0), pw2[1]=PKW(P1,2), pw2); \
    VRD(6); SBAR(); GAPA(C1=__builtin_amdgcn_mfma_f32_32x32x16_bf16(kf[5],qr[2],C1,0,0,0),   P1[6],P1[7],P1[8],P1[9],     pw2[2]=PKW(P1,4), pw2[3]=PKW(P1,6), pw2); \
    VRD(3); SBAR(); GAPA(C0=__builtin_amdgcn_mfma_f32_32x32x16_bf16(kf[6],qr[3],C0,0,0,0),   P1[10],P1[11],P1[12],P1[13], pw3[0]=PKW(P1,8), pw3[1]=PKW(P1,10), pw3); \
    VRD(7); SBAR(); GAPA(C1=__builtin_amdgcn_mfma_f32_32x32x16_bf16(kf[7],qr[3],C1,0,0,0),   P1[14],P1[15],0.f,0.f,       pw3[2]=PKW(P1,12),pw3[3]=PKW(P1,14), pw3); \
    l_reg+=sacc; \
    if(GK){DMA_K((t)+3,sl_cur);} if(GV){DMA_V((t)+1,sl_next);} \
    CMASK(C0,C1,t); \
    { float a=MX3(C0[0],C0[1],C1[0]),b=MX3(C0[2],C0[3],C1[1]); a=MX3(a,C1[2],C1[3]); \
      _Pragma("unroll") for(int r=4;r<16;r+=4){a=MX3(a,C0[r],C0[r+1]);b=MX3(b,C0[r+2],C0[r+3]);a=MX3(a,C1[r],C1[r+1]);b=MX3(b,C1[r+2],C1[r+3]);} \
      float rm=__builtin_fmaxf(a,b); { auto rr=__builtin_amdgcn_permlane32_swap(__float_as_uint(rm),__float_as_uint(rm),false,false); rm=__builtin_fmaxf(__uint_as_float(rr[0]),__uint_as_float(rr[1])); } \
      resc=false; \
      if(__builtin_expect(__any(rm>(float)THRL),0)){ const float dl=__builtin_fmaxf(rm,0.f); mhat+=dl; \
        _Pragma("unroll") for(int r=0;r<16;++r){C0[r]-=dl;C1[r]-=dl;} \
        const float f=__builtin_amdgcn_exp2f(-dl); l_reg*=f; if(hi==0)wsf[r32]=f; resc=true; } } \
    SBAR(); \
    if(GL){INITLD(P0,P1,(t)+1);} if(ZL){ _Pragma("unroll") for(int i_=0;i_<4;++i_) zg[i_]=*(const u32x4*)(Zw+(long)(i_*8)*DM); } SBAR(); \
    GAPB(o[0]=__builtin_amdgcn_mfma_f32_32x32x16_bf16(PAF(0),VFR(0),o[0],0,0,0), C0,0); \
    GAPB(o[1]=__builtin_amdgcn_mfma_f32_32x32x16_bf16(PAF(0),VFR(4),o[1],0,0,0), C0,4); \
    KRD(GL,0); GAPB(o[0]=__builtin_amdgcn_mfma_f32_32x32x16_bf16(PAF(1),VFR(1),o[0],0,0,0), C0,8); \
    KRD(GL,1); GAPB(o[1]=__builtin_amdgcn_mfma_f32_32x32x16_bf16(PAF(1),VFR(5),o[1],0,0,0), C0,12); \
    KRD(GL,2); GAPB(o[0]=__builtin_amdgcn_mfma_f32_32x32x16_bf16(PAF(2),VFR(2),o[0],0,0,0), C1,0); \
    KRD(GL,3); GAPB(o[1]=__builtin_amdgcn_mfma_f32_32x32x16_bf16(PAF(2),VFR(6),o[1],0,0,0), C1,4); \
    GAPB(o[0]=__builtin_amdgcn_mfma_f32_32x32x16_bf16(PAF(3),VFR(3),o[0],0,0,0), C1,8); \
    GAPB(o[1]=__builtin_amdgcn_mfma_f32_32x32x16_bf16(PAF(3),VFR(7),o[1],0,0,0), C1,12); \
    if(GL){INITSUB(P0,P1);} \
    }while(0)
  u32x4 zg[4]; const bf16*Zw=nullptr;
  int t=1;
  #undef CMASK
  #define CMASK(P0,P1,t) do{}while(0)
  for(;t+5<NT;t+=2){
    STEP(pB0,pB1,pA0,pA1,t,true,true,true,false);     WAIT_BAR(2); RESC(); ROT();
    STEP(pA0,pA1,pB0,pB1,t+1,true,true,true,false);   WAIT_BAR(2); RESC(); ROT();
  }
  #undef CMASK
  #define CMASK(P0,P1,t) do{int jb_=(t)-(NT-4); if(jb_>=0)cmask(P0,P1,jb_,qrel,hi);}while(0)
  #define ENDW(tt) do{ if((tt)+3<NT){WAIT_BAR(2);} else if((tt)+2<NT){WAIT_BAR(1);} else {WAIT_BAR(0);} }while(0)
  for(;t+1<NT;t+=2){
    STEP(pB0,pB1,pA0,pA1,t,(t+3<NT),(t+1<NT),(t+1<NT),false);       ENDW(t);   RESC(); ROT();
    STEP(pA0,pA1,pB0,pB1,t+1,(t+4<NT),(t+2<NT),(t+2<NT),false);     ENDW(t+1); RESC(); ROT();
  }
  int lane_e=lane; asm volatile("":"+v"(lane_e)); const long eoff=(long)(lane_e>>3)*DM+(lane_e&7)*8;
  Zw=SZ+(rowbase+q0+wid*QBLK)*DM+h*D+eoff;
  STEP(pB0,pB1,pA0,pA1,NT-1,false,false,false,true); RESC();
  int nxt_=NUNITS,qbn_=0; float tv0=0.f,tv1=0.f,tv2=0.f,tv3=0.f,ta=0.f,tb=0.f,tc=0.f;
  if(wid==0){ nxt_=__builtin_amdgcn_readfirstlane((int)nraw);
    if(nxt_<NUNITS){ const int hn_=__builtin_amdgcn_readfirstlane(hor[nxt_>>6]); qbn_=(NQB-1)-(nxt_&(NQB-1));
      const float* tp=TOT+hn_*(SEQ/KVBLK); const int j0n=4*qbn_, base=j0n-1-4*lane;
      tv0=base>=0?tp[base>=0?base:0]:0.f; tv1=base-1>=0?tp[base-1>=0?base-1:0]:0.f; tv2=base-2>=0?tp[base-2>=0?base-2:0]:0.f; tv3=base-3>=0?tp[base-3>=0?base-3:0]:0.f;
      ta=tp[j0n]; tb=tp[j0n+1]; tc=tp[j0n+2]; } }
  { float sacc=pB0[0]+pB0[1]; _Pragma("unroll") for(int r=2;r<16;++r)sacc+=pB0[r]; _Pragma("unroll") for(int r=0;r<16;++r)sacc+=pB1[r]; l_reg+=sacc;
    pw0=(u32x4){PKW(pB0,0),PKW(pB0,2),PKW(pB0,4),PKW(pB0,6)};pw1=(u32x4){PKW(pB0,8),PKW(pB0,10),PKW(pB0,12),PKW(pB0,14)};pw2=(u32x4){PKW(pB1,0),PKW(pB1,2),PKW(pB1,4),PKW(pB1,6)};pw3=(u32x4){PKW(pB1,8),PKW(pB1,10),PKW(pB1,12),PKW(pB1,14)};
    SBAR(); pv(o,vb0+sl_cur,PAF(0),PAF(1),PAF(2),PAF(3)); }
  #undef PKW
  #undef PAF
  #undef VFR
  #undef PIN
  #undef MX3
  #undef GAPA
  #undef GAPB
  #undef EX
  #undef VRD
  #undef KRD
  #undef STEP
  #undef ENDW
  {auto rr=__builtin_amdgcn_permlane32_swap(__float_as_uint(l_reg),__float_as_uint(l_reg),false,false);l_reg=__uint_as_float(rr[0])+__uint_as_float(rr[1]);}
  if(hi==0)wsf[32+r32]=l_reg;asm volatile("s_waitcnt lgkmcnt(0)":::"memory");
  float rli[16];
  #pragma unroll
  for(int r=0;r<16;++r)rli[r]=__builtin_amdgcn_rcpf(wsf[32+crow(r,hi)]);
  bf16*Ow=O+(rowbase+q0+wid*QBLK)*DM+h*D+eoff;
  { bf16*stg=(bf16*)(shm+LDS_OST)+wid*2048;
    #pragma unroll
    for(int r=0;r<16;++r){const int orow=crow(r,hi);
      #pragma unroll
      for(int d0=0;d0<2;++d0)stg[orow*64+d0*32+r32]=__float2bfloat16(o[d0][r]*rli[r]);}
    asm volatile("s_waitcnt lgkmcnt(0)":::"memory");
    #pragma unroll
    for(int i=0;i<4;++i){const int row=i*8+(lane_e>>3),ch=lane_e&7; const u32x4 v=*(const u32x4*)(stg+row*64+ch*8); u32x4 w;
      _Pragma("unroll") for(int c=0;c<4;++c)w[c]=cvtpk_s(bflo(v[c])*bflo(zg[i][c]),bfhi(v[c])*bfhi(zg[i][c]));
      ATTN_STORE16(Ow+(long)(i*8)*DM,w);} }
  if(wid==0){ const int ns=ui^1;
    if(nxt_<NUNITS){ attn_tables_fin(qbn_,tv0,tv1,tv2,tv3,ta,tb,tc,negTH,ns,shm,lane); }
    if(lane==0)((__attribute__((address_space(3))) int*)((lds_cptr)shm+LDS_RT+8192+32))[ns]=nxt_; }
  asm volatile("s_waitcnt lgkmcnt(0)\n\ts_barrier":::"memory");
  #undef CBIAS
  #undef INITLD
  #undef INITSUB
  #undef DMA_K
  #undef DMA_V
  #undef CMASK
  #undef START
  #undef RESC
  #undef ROT
}
constexpr int ATTN_LDS_BYTES=LDS_ALL;
#undef SBAR
#undef WAIT_BAR
}
constexpr int NWAVES = 8;
constexpr int SEQ = 16384, D = 1024, H = 16, HD = 64, NIN = 4 * D, LDW3 = 4 * D + H;
constexpr float RMS_EPS = 1e-6f;
constexpr size_t MiB = 1u << 20;
constexpr size_t WS_CTL = 0, CTL_ZERO_BYTES = 16384; constexpr int CW_QUEUE = 3584;
constexpr size_t WS_W1 = 2 * MiB, WS_W2 = 10 * MiB, WS_W3 = 12 * MiB, WS_W4 = 20 * MiB, WS_WF = 22 * MiB, WS_SSQ = 23 * MiB, WS_CL = 24 * MiB, WS_TOT = 25 * MiB, WS_RMS0 = 25 * MiB + 512 * 1024, WS_HU = 26 * MiB, WS_HG = 27 * MiB, WS_TU = 28 * MiB;
constexpr size_t WS_XN = 32 * MiB, WS_U = 64 * MiB  , WS_GZ = 96 * MiB  , WS_Y = 128 * MiB, WS_X1B = 160 * MiB, WS_Q = 192 * MiB, WS_K = 224 * MiB, WS_END = 256 * MiB;
constexpr size_t WS_V = WS_U, WS_SZ = WS_GZ, WS_OG = WS_Y;
constexpr int RING_OFF = 0, RING_BYTES = 131072;
constexpr int LDS_BYTES = 160 * 1024;
static_assert(attn_body::ATTN_LDS_BYTES + 256 <= LDS_BYTES, "LDS map");
constexpr int HOR_OFF = attn_body::ATTN_LDS_BYTES;

#define GAS __attribute__((address_space(1)))
#define LAS __attribute__((address_space(3)))
typedef unsigned short bf16;
typedef unsigned v4u __attribute__((ext_vector_type(4)));
typedef float f32x4 __attribute__((ext_vector_type(4)));
typedef short bf16x8 __attribute__((ext_vector_type(8)));
#define LDS_WAIT() asm volatile("s_waitcnt lgkmcnt(0)" ::: "memory")
__device__ __forceinline__ unsigned f2bf(float f) { unsigned u = __builtin_bit_cast(unsigned, f); return (u + 0x7fffu + ((u >> 16) & 1u)) >> 16; }
__device__ __forceinline__ unsigned pk2(float lo, float hi) { return f2bf(lo) | (f2bf(hi) << 16); }
__device__ __forceinline__ float wave_sum(float v) {
#pragma unroll
    for (int o = 1; o < 64; o <<= 1) v += __shfl_xor(v, o);
    return v;
}
template <int MAP> __device__ __forceinline__ int colmap(int s) {
    if (MAP == 1) { const int mat = s >> 10, d = s & 1023; return 256 * (d >> 6) + 128 * (mat >> 1) + 32 * ((d >> 4) & 3) + 8 * ((d >> 2) & 3) + 4 * (mat & 1) + (d & 3); }
    if (MAP == 2) { return (s & ~255) + 128 * ((s >> 5) & 1) + 32 * ((s >> 6) & 3) + (s & 31); }
    return s;
}
template <int MAP> __device__ __forceinline__ void p0_transpose_item(const float* W, int K, int ldw, int N, const float* gk, bf16* WT, LAS float* scr, int item, int lane) {
    const int nblk = N / 32, kb = item / nblk, nb = item % nblk, k0 = 64 * kb, n0 = 32 * nb;
    { f32x4 w[8]; const int c4 = lane & 7, kr = lane >> 3;
#pragma unroll
      for (int i = 0; i < 8; ++i) w[i] = __builtin_nontemporal_load((const GAS f32x4*)(W + (size_t)(k0 + kr + 8 * i) * ldw + n0 + 4 * c4));
#pragma unroll
      for (int i = 0; i < 8; ++i) { const int kk = kr + 8 * i; f32x4 v = w[i]; if (gk) v = v * gk[k0 + kk];
          LAS float* d = scr + kk * 33 + 4 * c4; d[0] = v.x; d[1] = v.y; d[2] = v.z; d[3] = v.w; } }
    LDS_WAIT(); asm volatile("" ::: "memory");
    const int c = lane & 7;
#pragma unroll
    for (int j = 0; j < 4; ++j) { const int n = (lane >> 3) + 8 * j; const LAS float* s = scr + (8 * c) * 33 + n;
        v4u o; o.x = pk2(s[0 * 33], s[1 * 33]); o.y = pk2(s[2 * 33], s[3 * 33]); o.z = pk2(s[4 * 33], s[5 * 33]); o.w = pk2(s[6 * 33], s[7 * 33]);
        *(GAS v4u*)(WT + (size_t)colmap<MAP>(n0 + n) * K + k0 + 8 * c) = o; }
    LDS_WAIT(); asm volatile("" ::: "memory");
}
__device__ __forceinline__ void rms_row_to_bf16(const float* xrow, const float* g, bf16* orow, int lane) {
    const GAS f32x4* xr = (const GAS f32x4*)xrow + lane; const GAS f32x4* gr = (const GAS f32x4*)g + lane;
    f32x4 v[4]; float s = 0.f;
#pragma unroll
    for (int j = 0; j < 4; ++j) { v[j] = xr[64 * j]; s += (v[j].x * v[j].x + v[j].y * v[j].y) + (v[j].z * v[j].z + v[j].w * v[j].w); }
    const float inv = 1.f / sqrtf(wave_sum(s) * (1.f / D) + RMS_EPS);
    GAS unsigned long long* o8 = (GAS unsigned long long*)orow + lane;
#pragma unroll
    for (int j = 0; j < 4; ++j) { const f32x4 gg = gr[64 * j]; const f32x4 y = v[j] * inv * gg; o8[64 * j] = (unsigned long long)pk2(y.x, y.y) | ((unsigned long long)pk2(y.z, y.w) << 32); }
}
__device__ __forceinline__ void rms_4rows_to_bf16(const float* x0, const float* g, bf16* o0, size_t stride, int lane, float* rms_out, int rstride) {
    const GAS f32x4* gr = (const GAS f32x4*)g + lane;
    f32x4 v[4][4]; float s[4];
#pragma unroll
    for (int r = 0; r < 4; ++r)
#pragma unroll
        for (int j = 0; j < 4; ++j) v[r][j] = __builtin_nontemporal_load((const GAS f32x4*)(x0 + r * stride) + lane + 64 * j);
#pragma unroll
    for (int r = 0; r < 4; ++r) { float a = 0.f;
#pragma unroll
        for (int j = 0; j < 4; ++j) a += (v[r][j].x * v[r][j].x + v[r][j].y * v[r][j].y) + (v[r][j].z * v[r][j].z + v[r][j].w * v[r][j].w);
        const float ms = wave_sum(a) * (1.f / D) + RMS_EPS; s[r] = 1.f / sqrtf(ms); if (lane == 0) rms_out[r * rstride] = sqrtf(ms); }
#pragma unroll
    for (int j = 0; j < 4; ++j) { const f32x4 gg = gr[64 * j];
#pragma unroll
        for (int r = 0; r < 4; ++r) { const f32x4 y = v[r][j] * s[r] * gg; ((GAS unsigned long long*)(o0 + r * stride) + lane)[64 * j] = (unsigned long long)pk2(y.x, y.y) | ((unsigned long long)pk2(y.z, y.w) << 32); } }
}
__device__ __forceinline__ void rms_2rows_to_bf16(const float* xa, const float* xb, const float* g, bf16* oa, bf16* ob, int lane) {
    const GAS f32x4* ra = (const GAS f32x4*)xa + lane; const GAS f32x4* rb = (const GAS f32x4*)xb + lane; const GAS f32x4* gr = (const GAS f32x4*)g + lane;
    f32x4 va[4], vb[4]; float sa = 0.f, sb = 0.f;
#pragma unroll
    for (int j = 0; j < 4; ++j) { va[j] = ra[64 * j]; vb[j] = rb[64 * j]; }
#pragma unroll
    for (int j = 0; j < 4; ++j) { sa += (va[j].x * va[j].x + va[j].y * va[j].y) + (va[j].z * va[j].z + va[j].w * va[j].w); sb += (vb[j].x * vb[j].x + vb[j].y * vb[j].y) + (vb[j].z * vb[j].z + vb[j].w * vb[j].w); }
    const float ia = 1.f / sqrtf(wave_sum(sa) * (1.f / D) + RMS_EPS), ib = 1.f / sqrtf(wave_sum(sb) * (1.f / D) + RMS_EPS);
    GAS unsigned long long* o8a = (GAS unsigned long long*)oa + lane; GAS unsigned long long* o8b = (GAS unsigned long long*)ob + lane;
#pragma unroll
    for (int j = 0; j < 4; ++j) { const f32x4 gg = gr[64 * j]; const f32x4 ya = va[j] * ia * gg, yb = vb[j] * ib * gg;
        o8a[64 * j] = (unsigned long long)pk2(ya.x, ya.y) | ((unsigned long long)pk2(ya.z, ya.w) << 32); o8b[64 * j] = (unsigned long long)pk2(yb.x, yb.y) | ((unsigned long long)pk2(yb.z, yb.w) << 32); }
}
__device__ __forceinline__ float bf_lo(unsigned w) { return __uint_as_float(w << 16); }
__device__ __forceinline__ float bf_hi(unsigned w) { return __uint_as_float(w & 0xffff0000u); }

typedef GAS unsigned gu32;
#define RLX_AGENT __ATOMIC_RELAXED, __HIP_MEMORY_SCOPE_AGENT
#define XB_TMO      128
#define XB_XCNT(j)  (256  + 64 * (j))
#define XB_XSUB(j)  (1280 + 64 * (j))
#define XB_XGEN(j)  (2304 + 64 * (j))
#define XB_TOP      3328
#define XB_TOPGEN   3392
#define XCD_BAR_WORDS 3456
#define XB_SPIN_CAP (1u << 18)

__device__ __forceinline__ unsigned xb_ld(unsigned* p)              { return __hip_atomic_load(p, __ATOMIC_RELAXED, __HIP_MEMORY_SCOPE_AGENT); }
__device__ __forceinline__ unsigned xb_add(unsigned* p, unsigned v) { return __hip_atomic_fetch_add(p, v, __ATOMIC_RELAXED, __HIP_MEMORY_SCOPE_AGENT); }
__device__ __forceinline__ unsigned xb_xcc_id() { return (unsigned)__builtin_amdgcn_s_getreg((3 << 11) | 20) & 0xFu; }
#define XB_SPIN(cond, bar) do { unsigned _sp = 0; while (cond) { __builtin_amdgcn_s_sleep(1); \
    if ((++_sp & 255u) == 0u) { if (xb_ld(&(bar)[XB_TMO])) break; if (_sp > XB_SPIN_CAP) { atomicAdd(&(bar)[XB_TMO], 1u); break; } } } } while (0)

struct XcdBarrier {
    unsigned* bar; unsigned x;
    volatile LAS unsigned* st;
};

__device__ __forceinline__ XcdBarrier xcd_barrier_post(unsigned* bar, volatile LAS unsigned* st) {
    XcdBarrier b; b.bar = bar; b.x = xb_xcc_id(); b.st = st;
    if (threadIdx.x == 0) (void)xb_add(&bar[XB_XCNT(b.x)], 1u);
    return b;
}
__device__ __forceinline__ void xcd_barrier_complete(unsigned* bar, unsigned x, unsigned& nloc, unsigned& nx) {
    const unsigned G = gridDim.x * gridDim.y * gridDim.z;
    unsigned sum, cnt, mine, sp = 0u;
    for (;;) {
        sum = 0u; cnt = 0u; mine = 0u;
#pragma unroll
        for (unsigned j = 0; j < 16; ++j) { const unsigned c = xb_ld(&bar[XB_XCNT(j)]); sum += c; cnt += (c > 0u) ? 1u : 0u; mine = (j == x) ? c : mine; }
        if (sum == G) break;
        __builtin_amdgcn_s_sleep(1);
        if ((++sp & 255u) == 0u) { if (xb_ld(&bar[XB_TMO])) break; if (sp > XB_SPIN_CAP) { atomicAdd(&bar[XB_TMO], 1u); break; } }
    }
    nloc = mine > 0u ? mine : 1u; nx = cnt > 0u ? cnt : 1u;
}

__device__ __forceinline__ void xcd_barrier(const XcdBarrier& b) {
    asm volatile("s_waitcnt vmcnt(0)" ::: "memory");
    __syncthreads();
    if (threadIdx.x == 0) {
        unsigned* bar = b.bar;
        __builtin_amdgcn_s_waitcnt(0);
        unsigned nloc = b.st[0], nx = b.st[1];
        if (nloc == 0u) { xcd_barrier_complete(bar, b.x, nloc, nx); b.st[0] = nloc; b.st[1] = nx; }
        const unsigned old = xb_add(&bar[XB_XSUB(b.x)], 1u);
        const unsigned gen = old / nloc;
        if (old + 1u == (gen + 1u) * nloc) {
            __builtin_amdgcn_fence(__ATOMIC_RELEASE, "agent");
            asm volatile("s_waitcnt vmcnt(0)" ::: "memory");
            const unsigned og = xb_add(&bar[XB_TOP], 1u);
            const unsigned tg = og / nx;
            if (og + 1u == (tg + 1u) * nx) xb_add(&bar[XB_TOPGEN], 1u);
            else XB_SPIN(xb_ld(&bar[XB_TOPGEN]) == tg, bar);
            __builtin_amdgcn_fence(__ATOMIC_ACQUIRE, "agent");
            xb_add(&bar[XB_XGEN(b.x)], 1u);
            asm volatile("s_waitcnt vmcnt(0)" ::: "memory");
        } else {
            XB_SPIN(xb_ld(&bar[XB_XGEN(b.x)]) == gen, bar);
            __builtin_amdgcn_fence(__ATOMIC_ACQUIRE, "agent");
            asm volatile("s_waitcnt vmcnt(0)" ::: "memory");
        }
    }
    __syncthreads();
}

struct Args { const float* in[11]; float* out; unsigned char* ws; int cg_seams; int pad; };

__global__ void __launch_bounds__(NWAVES * 64, 2) fwd_megakernel(Args args) {
    extern __shared__ __attribute__((aligned(16))) unsigned char lds[];
    cg::grid_group grid = cg::this_grid();
    LAS unsigned char* ldsL = (LAS unsigned char*)lds;
    const int tid = threadIdx.x, lane = tid & 63, wave = __builtin_amdgcn_readfirstlane(tid >> 6);
    const int G = gridDim.x; const int bx = blockIdx.x; const int vcu = (G % 8 == 0) ? (bx % 8) * (G / 8) + bx / 8 : bx;
    unsigned char* ws = args.ws;
    const float* x = args.in[0]; const float* conv_norm_g = args.in[1]; const float* conv_w_in = args.in[2]; const float* conv_w = args.in[3]; const float* conv_w_out = args.in[4];
    const float* attn_norm_g = args.in[5]; const float* attn_w_in = args.in[6]; const float* attn_b_f = args.in[7]; const float* q_g = args.in[8]; const float* k_g = args.in[9]; const float* attn_w_out = args.in[10];
    float* out = args.out;
    bf16 *W1t = (bf16*)(ws + WS_W1), *W2t = (bf16*)(ws + WS_W2), *W3t = (bf16*)(ws + WS_W3), *W4t = (bf16*)(ws + WS_W4), *Wft = (bf16*)(ws + WS_WF);
    float *SSQ = (float*)(ws + WS_SSQ), *CL = (float*)(ws + WS_CL), *TOT = (float*)(ws + WS_TOT);
    bf16 *XN = (bf16*)(ws + WS_XN), *Y = (bf16*)(ws + WS_Y), *X1B = (bf16*)(ws + WS_X1B);
    float *RMS0 = (float*)(ws + WS_RMS0);
    float *HU = (float*)(ws + WS_HU), *HG = (float*)(ws + WS_HG), *TU = (float*)(ws + WS_TU);
    bf16 *Qb = (bf16*)(ws + WS_Q), *Kb = (bf16*)(ws + WS_K), *Vb = (bf16*)(ws + WS_V), *SZ = (bf16*)(ws + WS_SZ), *OG = (bf16*)(ws + WS_OG);

    volatile LAS unsigned* MISC = (volatile LAS unsigned*)(ldsL + LDS_BYTES - 64);
    if (tid == 0) { MISC[0] = 0u; MISC[1] = 0u; }
    __syncthreads();
    const XcdBarrier bar = xcd_barrier_post((unsigned*)(ws + WS_CTL), MISC);
    {
        LAS float* scr = (LAS float*)(ldsL + RING_OFF + wave * 16384);
        const int gw = vcu * NWAVES + wave, NGW = G * NWAVES;
        constexpr int I1 = (D / 64) * (NIN / 32), I2 = (D / 64) * (D / 32), I3 = I1, I4 = I2, NITEMS = I1 + I2 + I3 + I4;
        for (int it = gw; it < NITEMS; it += NGW) {
            int r = it;
            if (r < I1) { p0_transpose_item<1>(conv_w_in, D, NIN, NIN, nullptr, W1t, scr, r, lane); continue; } r -= I1;
            if (r < I2) { p0_transpose_item<0>(conv_w_out, D, D, D, nullptr, W2t, scr, r, lane); continue; } r -= I2;
            if (r < I3) { p0_transpose_item<2>(attn_w_in, D, LDW3, NIN, attn_norm_g, W3t, scr, r, lane); continue; } r -= I3;
            p0_transpose_item<0>(attn_w_out, D, D, D, nullptr, W4t, scr, r, lane);
        }
        for (int i = gw * 64 + lane; i < H * D; i += NGW * 64) { const int h = i >> 10, k = i & 1023; Wft[i] = (bf16)f2bf(attn_w_in[(size_t)k * LDW3 + NIN + h] * attn_norm_g[k]); }
        for (int m = gw; m < SEQ; m += 4 * NGW) rms_4rows_to_bf16(x + (size_t)m * D, conv_norm_g, XN + (size_t)m * D, (size_t)NGW * D, lane, RMS0 + m, NGW);
    }
    if (args.cg_seams) grid.sync(); else xcd_barrier(bar);

    {
        pg8::Gemm g{XN, W1t, SEQ, NIN, D}; pg8::StaticOrder S; S.init(SEQ, NIN, G, bx);
        pg8::EpiConvIn E{Y, HU, HG, TU, conv_w, (LAS float*)(ldsL + RING_BYTES)};
        pg8::gemm_phase<pg8::EpiConvIn, pg8::StaticOrder, true, true>(ldsL + RING_OFF, g, S, E);
    }
    if (args.cg_seams) grid.sync(); else xcd_barrier(bar);

    {
        pg8::Gemm g{Y, W2t, SEQ, D, D}; pg8::StaticOrder S; S.init(SEQ, D, G, bx);
        { pg8::Unit pu; for (int i = 0; S.next(i, pu); ++i) { const int r = tid >> 8, ch = (tid & 255) * 4, pm = pu.pm;
              const f32x4 u0 = *(const f32x4*)(HU + ((size_t)pm * 2 + 0) * D + ch), u1 = *(const f32x4*)(HU + ((size_t)pm * 2 + 1) * D + ch), gz = *(const f32x4*)(HG + ((size_t)pm * 2 + r) * D + ch);
              f32x4 t0 = (f32x4){0.f, 0.f, 0.f, 0.f}, t1 = t0; if (pm > 0) { t0 = *(const f32x4*)(TU + ((size_t)(pm - 1) * 2 + 0) * D + ch); t1 = *(const f32x4*)(TU + ((size_t)(pm - 1) * 2 + 1) * D + ch); }
              const f32x4 w0 = *(const f32x4*)(conv_w + ch), w1 = *(const f32x4*)(conv_w + D + ch), w2 = *(const f32x4*)(conv_w + 2 * D + ch);
              const f32x4 y = r == 0 ? gz * (w0 * t0 + w1 * t1 + w2 * u0) : gz * (w0 * t1 + w1 * u0 + w2 * u1);
              unsigned long long o = (unsigned long long)pk2(y.x, y.y) | ((unsigned long long)pk2(y.z, y.w) << 32);
              *(unsigned long long*)(Y + ((size_t)pm * 256 + r) * D + ch) = o; }
          asm volatile("s_waitcnt vmcnt(0)" ::: "memory"); __syncthreads(); }
        pg8::EpiConvOut E{XN, RMS0, conv_norm_g, X1B, SSQ};
        pg8::gemm_phase<pg8::EpiConvOut, pg8::StaticOrder, true, true>(ldsL + RING_OFF, g, S, E);
    }
    if (args.cg_seams) grid.sync(); else xcd_barrier(bar);

    {
        typedef float f32x4m __attribute__((ext_vector_type(4)));
        LAS float* part = (LAS float*)(ldsL + RING_OFF);
        for (int chunk = bx; chunk < SEQ / 64; chunk += G) {
            const int t0 = chunk * 64, fr = lane & 15, fq = lane >> 4;
            const f32x4* sp = (const f32x4*)(SSQ + (size_t)(t0 + lane) * 16); const f32x4 sa = sp[0], sb = sp[1], sc = sp[2], sd = sp[3];
            f32x4m acc[4];
#pragma unroll
            for (int rb = 0; rb < 4; ++rb) acc[rb] = (f32x4m){0.f, 0.f, 0.f, 0.f};
#pragma unroll
            for (int ks = 0; ks < 4; ++ks) { const int k0 = wave * 128 + ks * 32 + fq * 8;
                const bf16x8 b = *(const bf16x8*)(Wft + (size_t)fr * D + k0);
#pragma unroll
                for (int rb = 0; rb < 4; ++rb) { const bf16x8 a = *(const bf16x8*)(X1B + (size_t)(t0 + rb * 16 + fr) * D + k0); acc[rb] = __builtin_amdgcn_mfma_f32_16x16x32_bf16(a, b, acc[rb], 0, 0, 0); } }
#pragma unroll
            for (int rb = 0; rb < 4; ++rb)
#pragma unroll
                for (int j = 0; j < 4; ++j) part[(wave * 64 + rb * 16 + fq * 4 + j) * 16 + fr] = acc[rb][j];
            __syncthreads();
            { const int row = t0 + lane;
              const float ss = ((sa[0] + sa[1]) + (sa[2] + sa[3])) + ((sb[0] + sb[1]) + (sb[2] + sb[3])) + ((sc[0] + sc[1]) + (sc[2] + sc[3])) + ((sd[0] + sd[1]) + (sd[2] + sd[3]));
              const float rs = 1.f / sqrtf(ss * (1.0f / 1024.0f) + RMS_EPS);
#pragma unroll
              for (int hh = 0; hh < 2; ++hh) { const int h = 2 * wave + hh; float v = 0.f;
#pragma unroll
                  for (int w = 0; w < 8; ++w) v += part[(w * 64 + lane) * 16 + h];
                  const float logit = v * rs + attn_b_f[h];
                  float lf = fminf(logit, 0.f) - 0.6931471805599453f * __builtin_amdgcn_logf(1.0f + __builtin_amdgcn_exp2f(-1.4426950408889634f * fabsf(logit)));
#pragma unroll
                  for (int o = 1; o < 64; o <<= 1) { const float y = __shfl_up(lf, o); if (lane >= o) lf += y; }
                  CL[(size_t)h * SEQ + row] = lf; if (lane == 63) TOT[h * (SEQ / 64) + chunk] = lf; } }
            asm volatile("s_waitcnt lgkmcnt(0)" ::: "memory"); __builtin_amdgcn_s_barrier(); asm volatile("" ::: "memory");
        }
    }
    {
        pg8::Gemm g{X1B, W3t, SEQ, NIN, D}; pg8::StaticOrder S; S.init(SEQ, NIN, G, bx);
        pg8::EpiAttnIn E{Qb, Kb, Vb, SZ, SSQ, q_g, k_g, attn_body::C2};
        pg8::gemm_phase<pg8::EpiAttnIn, pg8::StaticOrder, true, true>(ldsL + RING_OFF, g, S, E);
    }
        LAS int* hor = (LAS int*)(ldsL + HOR_OFF);
        float mq = 0.f, mk = 0.f;
        for (int i = 0; i < HD; ++i) { mq = fmaxf(mq, fabsf(q_g[i])); mk = fmaxf(mk, fabsf(k_g[i])); }
        const float negTH = -(20.0f + 2.0f * 8.2f * mq * mk);
        if (tid < H) { const float me = attn_b_f[tid]; int rank = 0;
            for (int h2 = 0; h2 < H; ++h2) { const float o = attn_b_f[h2]; rank += ((o > me) || (o == me && h2 < tid)) ? 1 : 0; }
            hor[rank] = tid; }
        unsigned* ctr = (unsigned*)(ws + WS_CTL) + CW_QUEUE;
        unsigned first_raw = 0u; if (wave == 0 && lane == 0) first_raw = __hip_atomic_fetch_add(ctr, 1u, __ATOMIC_RELAXED, __HIP_MEMORY_SCOPE_AGENT);
    if (args.cg_seams) grid.sync(); else xcd_barrier(bar);

    {
        LAS int* idw = (LAS int*)(ldsL + RING_OFF + attn_body::LDS_RT + 8192 + 32);
        if (wave == 0) { const int nxt = __builtin_amdgcn_readfirstlane((int)first_raw);
            if (nxt < attn_body::NUNITS) attn_body::attn_tables(__builtin_amdgcn_readfirstlane(hor[nxt >> 6]), 63 - (nxt & 63), TOT, negTH, 0, (char*)lds + RING_OFF, lane);
            if (lane == 0) idw[0] = nxt; }
        __syncthreads();
        for (int k = 0;; ++k) { const int cur = __builtin_amdgcn_readfirstlane(idw[k & 1]); if (cur >= attn_body::NUNITS) break;
            const int h = __builtin_amdgcn_readfirstlane(hor[cur >> 6]), qb = 63 - (cur & 63);
            attn_body::attn_unit<60>(h, qb, (const attn_body::bf16*)Qb, (const attn_body::bf16*)Kb, (const attn_body::bf16*)Vb, (const attn_body::bf16*)SZ, (attn_body::bf16*)OG, CL, k & 1, ctr, TOT, negTH, hor, (char*)lds + RING_OFF); }
    }
    if (args.cg_seams) grid.sync(); else xcd_barrier(bar);

    {
        pg8::Gemm g{OG, W4t, SEQ, D, D}; pg8::StaticOrder S; S.init(SEQ, D, G, bx);
        pg8::EpiOut E{X1B, out};
        pg8::gemm_phase<pg8::EpiOut, pg8::StaticOrder, true, true>(ldsL + RING_OFF, g, S, E);
    }
}

extern "C" void kernel_launch(void* const* d_in, const int* in_sizes, int n_in, void* d_out, int out_size, void* d_ws, size_t ws_size, hipStream_t stream) {
    static int grid = 0;
    if (grid == 0) {
        if (n_in != 11 ||   false || in_sizes[0] != SEQ * D || out_size != SEQ * D || ws_size < WS_END) { fprintf(stderr, "kernel_launch: unexpected shapes (n_in %d, in0 %d, out %d, ws %zu); nothing launched\n", n_in, n_in > 0 ? in_sizes[0] : -1, out_size, ws_size); grid = -1; return; }
        int dev = 0, cus = 0, per_cu = 0;
        if (hipGetDevice(&dev) != hipSuccess || hipDeviceGetAttribute(&cus, hipDeviceAttributeMultiprocessorCount, dev) != hipSuccess) { grid = -1; return; }
        if (hipFuncSetAttribute((const void*)fwd_megakernel, hipFuncAttributeMaxDynamicSharedMemorySize, LDS_BYTES) != hipSuccess) { fprintf(stderr, "kernel_launch: hipFuncSetAttribute failed\n"); grid = -1; return; }
        if (hipOccupancyMaxActiveBlocksPerMultiprocessor(&per_cu, (const void*)fwd_megakernel, NWAVES * 64, LDS_BYTES) != hipSuccess || per_cu < 1) { fprintf(stderr, "kernel_launch: occupancy query says %d\n", per_cu); per_cu = 1; }
        (void)hipGetLastError();
        grid = cus; if (grid * NWAVES < H * (SEQ / 256)) { fprintf(stderr, "kernel_launch: needs >= 128 CUs\n"); grid = -1; return; }
    }
    if (grid < 0) return;
    if (hipMemsetAsync((char*)d_ws + WS_CTL, 0, CTL_ZERO_BYTES, stream) != hipSuccess) { fprintf(stderr, "kernel_launch: hipMemsetAsync failed\n"); return; }
    Args a{};
    for (int i = 0; i < 11; ++i) a.in[i] = (const float*)d_in[i];
    a.out = (float*)d_out; a.ws = (unsigned char*)d_ws; a.cg_seams = 0; a.pad = 0;
    void* kargs[] = {&a};
    hipError_t e = hipLaunchCooperativeKernel((const void*)fwd_megakernel, dim3(grid), dim3(NWAVES * 64), kargs, LDS_BYTES, stream);
    if (e != hipSuccess) fprintf(stderr, "kernel_launch: cooperative launch failed: %s (grid %d)\n", hipGetErrorString(e), grid);
}
```

```cpp
#include <hip/hip_runtime.h>
#include <hip/hip_cooperative_groups.h>
#include <cstdio>
#include <cstdint>
namespace cg = cooperative_groups;
namespace pg8 {
#define PG8_LAS __attribute__((address_space(3)))
typedef unsigned short bf16_t;
typedef short bf16x8 __attribute__((ext_vector_type(8)));
typedef float f32x4 __attribute__((ext_vector_type(4)));
typedef unsigned u32x4 __attribute__((ext_vector_type(4)));
constexpr int BM = 256, BK = 64, HALF = 128, HTB = HALF * BK * 2  , STAGE_BYTES = 8 * HTB, NXCD = 8, WGM = 8;

__host__ __device__ __forceinline__ int lds_byte(int r, int c) { const int st = (r >> 4) * 2 + (c >> 5), rr = r & 15, cc = c & 31, ob = rr * 64 + cc * 2; return st * 1024 + (ob ^ (((ob >> 9) & 1) << 5)); }
__host__ __device__ __forceinline__ void stage_rc(int b, int& R, int& C) { const int st = b / 1024, sb = b % 1024, swz = sb ^ (((sb >> 9) & 1) << 5); R = (st >> 1) * 16 + swz / 64; C = (st & 1) * 32 + (swz % 64) / 2; }
__host__ __device__ __forceinline__ int perm32(int rho) { const int n = rho >> 4, i = rho & 15; return 8 * (i >> 2) + 4 * n + (i & 3); }

struct Unit { int pm, pn; };
struct Gemm { const bf16_t* A; const bf16_t* Bt; int M, N, K; };

struct StaticOrder {
    int nM, nN, nwg, G, c;
    __host__ __device__ void init(int M, int N, int G_, int c_) { nM = M / BM; nN = N / BM; nwg = nM * nN; G = G_; c = c_; }
    __host__ __device__ bool next(int i, Unit& u) const {
        const long L = (long)i * G + c; if (L >= nwg) return false;
        int wgid = (int)L; { const int q = nwg / NXCD, r = nwg % NXCD, xcd = wgid % NXCD, off = wgid / NXCD; wgid = (xcd < r ? xcd * (q + 1) : r * (q + 1) + (xcd - r) * q) + off; }
        const int nig = WGM * nN, gid = wgid / nig, fm = gid * WGM, gsz = (nM - fm) < WGM ? (nM - fm) : WGM;
        u.pm = fm + ((wgid % nig) % gsz); u.pn = (wgid % nig) / gsz; return true;
    }
    __device__ __forceinline__ void a_ready(const Unit&) const {}
    __device__ __forceinline__ void done(const Unit&) const {}
};


__device__ __forceinline__ unsigned cvt_pk_bf16(float lo, float hi) { unsigned r; asm volatile("v_cvt_pk_bf16_f32 %0, %1, %2" : "=v"(r) : "v"(lo), "v"(hi)); return r; }
typedef unsigned u32x2 __attribute__((ext_vector_type(2)));
__device__ __forceinline__ float sigmoid_f(float z) { return __builtin_amdgcn_rcpf(1.0f + __builtin_amdgcn_exp2f(-1.4426950408889634f * z)); }

template <int N> __device__ __forceinline__ float dpp_ror(float v) { return __builtin_bit_cast(float, __builtin_amdgcn_mov_dpp(__builtin_bit_cast(int, v), 0x120 + N, 0xf, 0xf, false)); }
struct EpiConvIn {
    static constexpr bool PERM = true, AFTER_DRAIN = false;
    bf16_t* Y; float* HU; float* HG; float* TU; const float* cw; PG8_LAS float* xb;
    __device__ __forceinline__ void operator()(const f32x4 (&acc)[2][2][4][2], const Unit& u, int wr, int wc, int fr, int fq) const {
        const int row0 = u.pm * BM + wr * 64 + fr, d0 = u.pn * 64 + wc * 16 + fq * 4, chl = wc * 16 + fq * 4;
        const f32x4 w0 = *(const f32x4*)(cw + d0), w1 = *(const f32x4*)(cw + 1024 + d0), w2 = *(const f32x4*)(cw + 2048 + d0);
#pragma unroll
        for (int ai = 0; ai < 2; ++ai) if (fr >= 14) { const f32x4 ut = acc[ai][0][3][1] * acc[ai][1][3][0];
            *(PG8_LAS f32x4*)(xb + ((2 * ai + wr) * 2 + (fr - 14)) * 64 + chl) = ut;
            if (ai == 1 && wr == 1) *(f32x4*)(TU + ((size_t)u.pm * 2 + (fr - 14)) * 1024 + d0) = ut; }
        asm volatile("s_waitcnt lgkmcnt(0)" ::: "memory"); __builtin_amdgcn_s_barrier(); asm volatile("" ::: "memory");
#pragma unroll
        for (int ai = 0; ai < 2; ++ai) { const int b = 2 * ai + wr; f32x4 up = (f32x4){0.f, 0.f, 0.f, 0.f};
#pragma unroll
            for (int m = 0; m < 4; ++m) { const int row = row0 + ai * HALF + m * 16;
                const f32x4 bq = acc[ai][0][m][0], c = acc[ai][0][m][1], xi = acc[ai][1][m][0], z = acc[ai][1][m][1];
                const f32x4 uu = c * xi; f32x4 g, p15 = (f32x4){0.f, 0.f, 0.f, 0.f}, p14 = p15, y;
#pragma unroll
                for (int e = 0; e < 4; ++e) g[e] = bq[e] * z[e] * sigmoid_f(z[e]);
                if (m == 0) { const int bp = b > 0 ? b - 1 : 0; p14 = *(const PG8_LAS f32x4*)(xb + (bp * 2 + 0) * 64 + chl); p15 = *(const PG8_LAS f32x4*)(xb + (bp * 2 + 1) * 64 + chl); }
#pragma unroll
                for (int e = 0; e < 4; ++e) { float u1 = dpp_ror<1>(uu[e]), u2 = dpp_ror<2>(uu[e]);
                    if (m == 0) { u1 = fr == 0 ? p15[e] : u1; u2 = fr == 0 ? p14[e] : (fr == 1 ? p15[e] : u2); }
                    else { const float q1 = dpp_ror<1>(up[e]), q2 = dpp_ror<2>(up[e]); u1 = fr == 0 ? q1 : u1; u2 = fr < 2 ? q2 : u2; }
                    y[e] = g[e] * (w0[e] * u2 + w1[e] * u1 + w2[e] * uu[e]); }
                up = uu;
                if (b == 0 && m == 0 && fr < 2) { *(f32x4*)(HU + ((size_t)u.pm * 2 + fr) * 1024 + d0) = uu; *(f32x4*)(HG + ((size_t)u.pm * 2 + fr) * 1024 + d0) = g; }
                else { u32x2 wy; wy.x = cvt_pk_bf16(y[0], y[1]); wy.y = cvt_pk_bf16(y[2], y[3]); *(u32x2*)(Y + (size_t)row * 1024 + d0) = wy; } } }
    }
};
struct EpiConvOut {
    static constexpr bool PERM = true, AFTER_DRAIN = false;
    const bf16_t* XN; const float* RMS0; const float* G0; bf16_t* X1B; float* SSQ;
    __device__ __forceinline__ void operator()(const f32x4 (&acc)[2][2][4][2], const Unit& u, int wr, int wc, int fr, int fq) const {
        const int row0 = u.pm * BM + wr * 64 + fr, col0 = u.pn * BM + wc * 32 + 8 * fq;
        f32x4 gi[2][2];
#pragma unroll
        for (int bj = 0; bj < 2; ++bj)
#pragma unroll
            for (int n = 0; n < 2; ++n) { const f32x4 gg = *(const f32x4*)(G0 + col0 + bj * HALF + n * 4); gi[bj][n] = (f32x4){1.0f / gg[0], 1.0f / gg[1], 1.0f / gg[2], 1.0f / gg[3]}; }
#pragma unroll
        for (int ai = 0; ai < 2; ++ai)
#pragma unroll
            for (int m = 0; m < 4; ++m) { const int row = row0 + ai * HALF + m * 16; float s = 0.f; const float rms = RMS0[row];
#pragma unroll
                for (int bj = 0; bj < 2; ++bj) { const size_t off = (size_t)row * 1024 + col0 + bj * HALF;
                    const u32x4 xw = *(const u32x4*)(XN + off);
                    const f32x4 x0 = {__uint_as_float(xw.x << 16), __uint_as_float(xw.x & 0xffff0000u), __uint_as_float(xw.y << 16), __uint_as_float(xw.y & 0xffff0000u)};
                    const f32x4 x1 = {__uint_as_float(xw.z << 16), __uint_as_float(xw.z & 0xffff0000u), __uint_as_float(xw.w << 16), __uint_as_float(xw.w & 0xffff0000u)};
                    const f32x4 v0 = x0 * gi[bj][0] * rms + acc[ai][bj][m][0], v1 = x1 * gi[bj][1] * rms + acc[ai][bj][m][1];
                    s += ((v0[0] * v0[0] + v0[1] * v0[1]) + (v0[2] * v0[2] + v0[3] * v0[3])) + ((v1[0] * v1[0] + v1[1] * v1[1]) + (v1[2] * v1[2] + v1[3] * v1[3]));
                    u32x4 w; w.x = cvt_pk_bf16(v0[0], v0[1]); w.y = cvt_pk_bf16(v0[2], v0[3]); w.z = cvt_pk_bf16(v1[0], v1[1]); w.w = cvt_pk_bf16(v1[2], v1[3]); *(u32x4*)(X1B + off) = w; }
                s += __shfl_xor(s, 16); s += __shfl_xor(s, 32);
                if (fq == 0) SSQ[(size_t)row * 16 + u.pn * 4 + wc] = s; }
    }
};
struct EpiAttnIn {
    static constexpr bool PERM = true, AFTER_DRAIN = false;
    bf16_t* Q; bf16_t* K; bf16_t* V; bf16_t* SZ; const float* SSQ; const float* gq; const float* gk; float qscale;
    __device__ __forceinline__ void operator()(const f32x4 (&acc)[2][2][4][2], const Unit& u, int wr, int wc, int fr, int fq) const {
        const int kind = u.pn >> 2, hb = (u.pn & 3) * 4 + wc, row0 = u.pm * BM + wr * 64 + fr, col0 = hb * 64 + 8 * fq;
        bf16_t* base = kind == 0 ? Q : kind == 1 ? K : kind == 2 ? V : SZ;
        const float* g = kind == 0 ? gq : gk; const float post = kind == 0 ? qscale : 1.0f;
        f32x4 gv[2][2];
#pragma unroll
        for (int bj = 0; bj < 2; ++bj)
#pragma unroll
            for (int n = 0; n < 2; ++n) gv[bj][n] = *(const f32x4*)(g + 32 * bj + 8 * fq + 4 * n);
        float rsv[2][4];
#pragma unroll
        for (int ai = 0; ai < 2; ++ai)
#pragma unroll
            for (int m = 0; m < 4; ++m) { const f32x4 sa = *((const f32x4*)(SSQ + (size_t)(row0 + ai * HALF + m * 16) * 16) + fq); rsv[ai][m] = (sa[0] + sa[1]) + (sa[2] + sa[3]); }
#pragma unroll
        for (int ai = 0; ai < 2; ++ai)
#pragma unroll
            for (int m = 0; m < 4; ++m) { float ss = rsv[ai][m]; ss += __shfl_xor(ss, 16); ss += __shfl_xor(ss, 32); rsv[ai][m] = __builtin_amdgcn_rsqf(ss * (1.0f / 1024.0f) + 1e-6f); }
#pragma unroll
        for (int ai = 0; ai < 2; ++ai)
#pragma unroll
            for (int m = 0; m < 4; ++m) { const int row = row0 + ai * HALF + m * 16;
                const float rs = rsv[ai][m];
                f32x4 v[2][2];
#pragma unroll
                for (int bj = 0; bj < 2; ++bj)
#pragma unroll
                    for (int n = 0; n < 2; ++n) v[bj][n] = acc[ai][bj][m][n] * rs;
                if (kind < 2) { float hs = 0.f;
#pragma unroll
                    for (int bj = 0; bj < 2; ++bj)
#pragma unroll
                        for (int n = 0; n < 2; ++n) { const f32x4 x = v[bj][n]; hs += (x[0] * x[0] + x[1] * x[1]) + (x[2] * x[2] + x[3] * x[3]); }
                    hs += __shfl_xor(hs, 16); hs += __shfl_xor(hs, 32);
                    const float r = __builtin_amdgcn_rsqf(hs * (1.0f / 64.0f) + 1e-6f) * post;
#pragma unroll
                    for (int bj = 0; bj < 2; ++bj)
#pragma unroll
                        for (int n = 0; n < 2; ++n) v[bj][n] = v[bj][n] * r * gv[bj][n];
                } else if (kind == 3) {
#pragma unroll
                    for (int bj = 0; bj < 2; ++bj)
#pragma unroll
                        for (int n = 0; n < 2; ++n)
#pragma unroll
                            for (int e = 0; e < 4; ++e) v[bj][n][e] = v[bj][n][e] * sigmoid_f(v[bj][n][e]);
                }
#pragma unroll
                for (int bj = 0; bj < 2; ++bj) { u32x4 w; w.x = cvt_pk_bf16(v[bj][0][0], v[bj][0][1]); w.y = cvt_pk_bf16(v[bj][0][2], v[bj][0][3]); w.z = cvt_pk_bf16(v[bj][1][0], v[bj][1][1]); w.w = cvt_pk_bf16(v[bj][1][2], v[bj][1][3]);
                    *(u32x4*)(base + (size_t)row * 1024 + col0 + 32 * bj) = w; } }
    }
};
struct EpiOut {
    static constexpr bool PERM = true, AFTER_DRAIN = false;
    const bf16_t* X1B; float* OUT;
    __device__ __forceinline__ void operator()(const f32x4 (&acc)[2][2][4][2], const Unit& u, int wr, int wc, int fr, int fq) const {
        const int row0 = u.pm * BM + wr * 64 + fr, col0 = u.pn * BM + wc * 32 + 8 * fq;
#pragma unroll
        for (int ai = 0; ai < 2; ++ai)
#pragma unroll
            for (int m = 0; m < 4; ++m)
#pragma unroll
                for (int bj = 0; bj < 2; ++bj) { const size_t off = (size_t)(row0 + ai * HALF + m * 16) * 1024 + col0 + bj * HALF; const u32x4 w = *(const u32x4*)(X1B + off);
                    const f32x4 b0 = {__uint_as_float(w.x << 16), __uint_as_float(w.x & 0xffff0000u), __uint_as_float(w.y << 16), __uint_as_float(w.y & 0xffff0000u)};
                    const f32x4 b1 = {__uint_as_float(w.z << 16), __uint_as_float(w.z & 0xffff0000u), __uint_as_float(w.w << 16), __uint_as_float(w.w & 0xffff0000u)};
                    __builtin_nontemporal_store(b0 + acc[ai][bj][m][0], (f32x4*)(OUT + off)); __builtin_nontemporal_store(b1 + acc[ai][bj][m][1], (f32x4*)(OUT + off + 4)); }
    }
};

template <class Epi, class Sched, bool ALIGN_EPI = false, bool SP2 = false>
__device__ __forceinline__ void gemm_phase(PG8_LAS unsigned char* lds, const Gemm g, const Sched& S, const Epi& E) {
    int tid_ = threadIdx.x; asm volatile("" : "+v"(tid_));
    const int tid = tid_, wid = __builtin_amdgcn_readfirstlane(tid >> 6), lane = tid & 63, wr = wid >> 2, wc = wid & 3, fr = lane & 15, fq = lane >> 4;
    const int K = g.K, nt = K / BK;
    unsigned voffA[2], voffB[2];
#pragma unroll
    for (int i = 0; i < 2; ++i) { int R, C; stage_rc(tid * 16 + i * 8192, R, C); const int Rb = Epi::PERM ? ((R & ~31) + perm32(R & 31)) : R;
        voffA[i] = (unsigned)(R * K + C) * 2u; voffB[i] = (unsigned)(Rb * K + C) * 2u; }
    const size_t kstep = (size_t)(BK * 2);
    const size_t hstep = (size_t)HALF * K * 2;
    const size_t tstep = 2 * hstep;
    const unsigned ldsw = (unsigned)wid * 1024u;
    const int aoff = lds_byte(wr * 64 + fr, fq * 8), boff = lds_byte(wc * 32 + fr, fq * 8);
#define PG8_SA(b, h) (((b) * 2 + (h)) * HTB)
#define PG8_SB(b, h) ((4 + (b) * 2 + (h)) * HTB)
#define PG8_STAGE(bufoff, gbase, voff) do { _Pragma("unroll") for (int _i = 0; _i < 2; ++_i) \
        __builtin_amdgcn_global_load_lds((const unsigned*)((const char*)(gbase) + (voff)[_i]), (PG8_LAS unsigned*)(lds + (bufoff) + ldsw + _i * 8192), 16, 0, 0); } while (0)
#define PG8_LDA(dst, b, h) do { _Pragma("unroll") for (int m = 0; m < 4; ++m) _Pragma("unroll") for (int k = 0; k < 2; ++k) dst[m][k] = *(const PG8_LAS bf16x8*)(lds + PG8_SA(b, h) + aoff + m * 2048 + k * 1024); } while (0)
#define PG8_LDB(dst, b, h) do { _Pragma("unroll") for (int n = 0; n < 2; ++n) _Pragma("unroll") for (int k = 0; k < 2; ++k) dst[n][k] = *(const PG8_LAS bf16x8*)(lds + PG8_SB(b, h) + boff + n * 2048 + k * 1024); } while (0)
#define PG8_MMA(ai, bj, At, Bt) do { __builtin_amdgcn_s_setprio(1); _Pragma("unroll") for (int m = 0; m < 4; ++m) _Pragma("unroll") for (int n = 0; n < 2; ++n) _Pragma("unroll") for (int k = 0; k < 2; ++k) \
        acc[ai][bj][m][n] = __builtin_amdgcn_mfma_f32_16x16x32_bf16(Bt[n][k], At[m][k], acc[ai][bj][m][n], 0, 0, 0); __builtin_amdgcn_s_setprio(0); } while (0)
#define PG8_WAIT_V(n) asm volatile("s_waitcnt vmcnt(" #n ")" ::: "memory")
#define PG8_WAIT_L(n) asm volatile("s_waitcnt lgkmcnt(" #n ")" ::: "memory")
#define PG8_BAR __builtin_amdgcn_s_barrier()
#define PG8_SCHED __builtin_amdgcn_sched_barrier(0)
    Unit cur, nxt; int ui = 0;
    if (!S.next(0, cur)) return;
    f32x4 acc[2][2][4][2];
#pragma unroll
    for (int a = 0; a < 2; ++a)
#pragma unroll
        for (int b = 0; b < 2; ++b)
#pragma unroll
            for (int m = 0; m < 4; ++m)
#pragma unroll
                for (int n = 0; n < 2; ++n) acc[a][b][m][n] = (f32x4){0.f, 0.f, 0.f, 0.f};
    bf16x8 At[4][2], B0[2][2], B1[2][2];
    const char* cA = (const char*)g.A + (size_t)cur.pm * tstep; const char* cB = (const char*)g.Bt + (size_t)cur.pn * tstep;
    S.a_ready(cur);
    if constexpr (SP2) {
        PG8_STAGE(PG8_SB(0, 0), cB, voffB); PG8_STAGE(PG8_SB(0, 1), cB + hstep, voffB); PG8_STAGE(PG8_SA(0, 0), cA, voffA); PG8_STAGE(PG8_SA(0, 1), cA + hstep, voffA);
        if (wr == 1) PG8_BAR;
        PG8_WAIT_V(2); PG8_BAR;
        PG8_STAGE(PG8_SB(1, 0), cB + kstep, voffB); PG8_STAGE(PG8_SA(1, 0), cA + kstep, voffA); PG8_STAGE(PG8_SB(1, 1), cB + hstep + kstep, voffB);
        PG8_WAIT_V(6); PG8_BAR;
    } else {
        PG8_STAGE(PG8_SB(0, 0), cB, voffB); PG8_STAGE(PG8_SA(0, 0), cA, voffA); PG8_STAGE(PG8_SB(0, 1), cB + hstep, voffB); PG8_STAGE(PG8_SA(0, 1), cA + hstep, voffA);
        if (wr == 1) PG8_BAR;
        PG8_WAIT_V(4); PG8_BAR;
        PG8_STAGE(PG8_SB(1, 0), cB + kstep, voffB); PG8_STAGE(PG8_SA(1, 0), cA + kstep, voffA); PG8_STAGE(PG8_SB(1, 1), cB + hstep + kstep, voffB);
        PG8_WAIT_V(6); PG8_BAR;
    }
    for (;;) {
        const bool has_next = S.next(ui + 1, nxt);
        const char* nA = has_next ? (const char*)g.A + (size_t)nxt.pm * tstep : cA; const char* nB = has_next ? (const char*)g.Bt + (size_t)nxt.pn * tstep : cB;
        for (int t = 0; t < nt; t += 2) {
            const bool last = (t == nt - 2);
            const char* a1 = cA + (size_t)(t + 1) * kstep;
            const char* a2 = last ? nA : cA + (size_t)(t + 2) * kstep; const char* b2 = last ? nB : cB + (size_t)(t + 2) * kstep;
            const char* a3 = a2 + kstep; const char* b3 = b2 + kstep;
            if (last && has_next) S.a_ready(nxt);
            if constexpr (SP2) {
            PG8_LDB(B0, 0, 0); PG8_LDB(B1, 0, 1); PG8_SCHED; PG8_LDA(At, 0, 0); PG8_STAGE(PG8_SA(1, 1), a1 + hstep, voffA);
            PG8_WAIT_V(8); PG8_WAIT_L(0); PG8_BAR; PG8_MMA(0, 0, At, B0); PG8_MMA(0, 1, At, B1); PG8_BAR; PG8_SCHED;
            PG8_LDA(At, 0, 1); PG8_STAGE(PG8_SB(0, 0), b2, voffB); PG8_STAGE(PG8_SB(0, 1), b2 + hstep, voffB); PG8_STAGE(PG8_SA(0, 0), a2, voffA);
            PG8_WAIT_V(8); PG8_WAIT_L(0); PG8_BAR; PG8_MMA(1, 0, At, B0); PG8_MMA(1, 1, At, B1); PG8_BAR; PG8_SCHED;
            PG8_LDB(B0, 1, 0); PG8_LDB(B1, 1, 1); PG8_SCHED; PG8_LDA(At, 1, 0); PG8_STAGE(PG8_SA(0, 1), a2 + hstep, voffA);
            PG8_WAIT_V(8); PG8_WAIT_L(0); PG8_BAR; PG8_MMA(0, 0, At, B0); PG8_MMA(0, 1, At, B1); PG8_BAR; PG8_SCHED;
            PG8_LDA(At, 1, 1); PG8_STAGE(PG8_SB(1, 0), b3, voffB); PG8_STAGE(PG8_SB(1, 1), b3 + hstep, voffB); PG8_STAGE(PG8_SA(1, 0), a3, voffA);
            PG8_WAIT_V(8); PG8_WAIT_L(0); PG8_BAR; PG8_MMA(1, 0, At, B0); PG8_MMA(1, 1, At, B1); PG8_BAR; PG8_SCHED;
            } else {
            PG8_LDB(B0, 0, 0); PG8_SCHED; PG8_LDA(At, 0, 0); PG8_STAGE(PG8_SA(1, 1), a1 + hstep, voffA);
            PG8_WAIT_L(8); PG8_BAR; PG8_WAIT_L(0); PG8_MMA(0, 0, At, B0); PG8_BAR; PG8_SCHED;
            PG8_LDB(B1, 0, 1); PG8_STAGE(PG8_SB(0, 0), b2, voffB);
            PG8_BAR; PG8_WAIT_L(0); PG8_MMA(0, 1, At, B1); PG8_BAR;
            PG8_LDA(At, 0, 1); PG8_STAGE(PG8_SA(0, 0), a2, voffA);
            PG8_BAR; PG8_WAIT_L(0); PG8_MMA(1, 0, At, B0); PG8_BAR; PG8_SCHED;
            PG8_STAGE(PG8_SB(0, 1), b2 + hstep, voffB);
            PG8_WAIT_V(6); PG8_BAR; PG8_MMA(1, 1, At, B1); PG8_BAR;
            PG8_LDB(B0, 1, 0); PG8_SCHED; PG8_LDA(At, 1, 0); PG8_STAGE(PG8_SA(0, 1), a2 + hstep, voffA);
            PG8_WAIT_L(8); PG8_BAR; PG8_WAIT_L(0); PG8_MMA(0, 0, At, B0); PG8_BAR; PG8_SCHED;
            PG8_LDB(B1, 1, 1); PG8_STAGE(PG8_SB(1, 0), b3, voffB);
            PG8_BAR; PG8_WAIT_L(0); PG8_MMA(0, 1, At, B1); PG8_BAR;
            PG8_LDA(At, 1, 1); PG8_STAGE(PG8_SA(1, 0), a3, voffA);
            PG8_BAR; PG8_WAIT_L(0); PG8_MMA(1, 0, At, B0); PG8_BAR; PG8_SCHED;
            PG8_STAGE(PG8_SB(1, 1), b3 + hstep, voffB);
            PG8_WAIT_V(6); PG8_BAR; PG8_MMA(1, 1, At, B1); PG8_BAR;
            }
        }
        if constexpr (ALIGN_EPI) { if (wr == 0) PG8_BAR; }
        if constexpr (!Epi::AFTER_DRAIN) { E(acc, cur, wr, wc, fr, fq); S.done(cur); }
        if (!has_next) break;
#pragma unroll
        for (int a = 0; a < 2; ++a)
#pragma unroll
            for (int b = 0; b < 2; ++b)
#pragma unroll
                for (int m = 0; m < 4; ++m)
#pragma unroll
                    for (int n = 0; n < 2; ++n) acc[a][b][m][n] = (f32x4){0.f, 0.f, 0.f, 0.f};
        cur = nxt; cA = nA; cB = nB; ++ui;
        if constexpr (ALIGN_EPI) { if (wr == 1) PG8_BAR; }
    }
    PG8_WAIT_V(0);
    if constexpr (!ALIGN_EPI) { if (wr == 0) PG8_BAR; }
    PG8_BAR;
    if constexpr (Epi::AFTER_DRAIN) { E.fused(acc, cur, wr, wc, fr, fq, lds, wid, lane); S.done(cur); }
#undef PG8_SA
#undef PG8_SB
#undef PG8_STAGE
#undef PG8_LDA
#undef PG8_LDB
#undef PG8_MMA
#undef PG8_WAIT_V
#undef PG8_WAIT_L
#undef PG8_BAR
#undef PG8_SCHED
}
}
#include <hip/hip_bf16.h>
#include <cmath>
namespace attn_body {
using bf16=__hip_bfloat16;
using bf16x8=__attribute__((ext_vector_type(8)))short;
using s16x4=__attribute__((ext_vector_type(4)))short;
using f32x16=__attribute__((ext_vector_type(16)))float;
using u32x4=__attribute__((ext_vector_type(4)))unsigned;
constexpr int BATCH=1,NHEAD=16,SEQ=16384,D=64,DM=NHEAD*D;
constexpr int NW=8,QBLK=32,QB=QBLK*NW,KVBLK=64,NQB=SEQ/QB;
constexpr int ATTN_PITCH=DM, ATTN_UNIT_ROWS=QB, NUNITS=NHEAD*NQB;
typedef __attribute__((address_space(3))) const char* lds_cptr;
__device__ __forceinline__ int crow(int r,int hi){return (r&3)+8*(r>>2)+4*hi;}
#define SBAR() __builtin_amdgcn_sched_barrier(0)
__device__ __forceinline__ void cmask(f32x16&p0,f32x16&p1,int jb,int qrel,int hi){
  const float NEG=-INFINITY; int kb=64*jb+4*hi;
  #pragma unroll
  for(int r=0;r<16;++r){int kv=kb+(r&3)+8*(r>>2); if(kv>qrel)p0[r]=NEG; if(kv+32>qrel)p1[r]=NEG;}
}

constexpr int NSLOT=3, SLOTB=8192;
constexpr int LDS_K=0, LDS_V=NSLOT*SLOTB, LDS_WS=2*NSLOT*SLOTB, LDS_OST=LDS_WS+NW*64*4, LDS_BYTES=LDS_OST+NW*4096, LDS_C2=LDS_BYTES, LDS_RT=LDS_C2+SEQ*4, LDS_ALL=LDS_RT+8192+64;
constexpr float C2=0.125f*1.4426950408889634f;
__device__ __forceinline__ void glds16(const void*gsrc,unsigned lds_dst){unsigned keep;
  asm volatile("s_mov_b32 %0, m0\n\ts_mov_b32 m0, %2\n\ts_nop 0\n\tglobal_load_lds_dwordx4 %1, off\n\ts_mov_b32 m0, %0":"=&s"(keep):"v"(gsrc),"s"(lds_dst):"memory");}
__device__ __forceinline__ float max3f(float a,float b,float c){float r;asm("v_max3_f32 %0, %1, %2, %3":"=v"(r):"v"(a),"v"(b),"v"(c));return r;}
__device__ __forceinline__ float max2f(float a,float b){float r;asm("v_max_f32_e32 %0, %1, %2":"=v"(r):"v"(a),"v"(b));return r;}
__device__ __forceinline__ float fadd_s(float a,float b){float r;asm("v_add_f32_e32 %0, %1, %2":"=v"(r):"v"(a),"v"(b));return r;}
__device__ __forceinline__ float fsub_s(float a,float b){float r;asm("v_sub_f32_e32 %0, %1, %2":"=v"(r):"v"(a),"v"(b));return r;}
typedef float f32x2_t __attribute__((ext_vector_type(2))); typedef __bf16 bf16x2_t __attribute__((ext_vector_type(2)));
__device__ __forceinline__ unsigned cvtpk_s(float lo,float hi){f32x2_t v={lo,hi};bf16x2_t b=__builtin_convertvector(v,bf16x2_t);return __builtin_bit_cast(unsigned,b);}
#define WAIT_BAR(N) asm volatile("s_waitcnt vmcnt(" #N ") lgkmcnt(0)\n\ts_barrier":::"memory")

__device__ __forceinline__ void qkt(f32x16&p0,f32x16&p1,const char*Kslot,const bf16x8*qr,const f32x16&negm,int r32,int hi){
  const char*kb=Kslot+hi*1024+r32*16;
  #pragma unroll
  for(int d0=0;d0<4;++d0){
    const bf16x8 b0=*reinterpret_cast<const bf16x8*>(kb+d0*2048);
    const bf16x8 b1=*reinterpret_cast<const bf16x8*>(kb+d0*2048+512);
    if(d0==0){p0=__builtin_amdgcn_mfma_f32_32x32x16_bf16(b0,qr[0],negm,0,0,0);p1=__builtin_amdgcn_mfma_f32_32x32x16_bf16(b1,qr[0],negm,0,0,0);}
    else{p0=__builtin_amdgcn_mfma_f32_32x32x16_bf16(b0,qr[d0],p0,0,0,0);p1=__builtin_amdgcn_mfma_f32_32x32x16_bf16(b1,qr[d0],p1,0,0,0);}}
}
typedef short v4i16_t __attribute__((ext_vector_type(4)));
__device__ __forceinline__ void kload8(bf16x8*kf,lds_cptr kp){
  kf[0]=*(const __attribute__((address_space(3))) bf16x8*)(kp);      kf[1]=*(const __attribute__((address_space(3))) bf16x8*)(kp+512);
  kf[2]=*(const __attribute__((address_space(3))) bf16x8*)(kp+2048); kf[3]=*(const __attribute__((address_space(3))) bf16x8*)(kp+2560);
  kf[4]=*(const __attribute__((address_space(3))) bf16x8*)(kp+4096); kf[5]=*(const __attribute__((address_space(3))) bf16x8*)(kp+4608);
  kf[6]=*(const __attribute__((address_space(3))) bf16x8*)(kp+6144); kf[7]=*(const __attribute__((address_space(3))) bf16x8*)(kp+6656);
}
__device__ __forceinline__ void kload2(bf16x8*kf,lds_cptr kp,int j){ kf[2*j]=*(const __attribute__((address_space(3))) bf16x8*)(kp+j*2048); kf[2*j+1]=*(const __attribute__((address_space(3))) bf16x8*)(kp+j*2048+512); }
__device__ __forceinline__ s16x4 vtr(lds_cptr p){ return __builtin_bit_cast(s16x4,__builtin_amdgcn_ds_read_tr16_b64_v4i16((__attribute__((address_space(3))) v4i16_t*)p)); }
__device__ __forceinline__ float rowmax(const f32x16&p0,const f32x16&p1){
  float a=max3f(p0[0],p0[1],p1[0]),b=max3f(p0[2],p0[3],p1[1]);a=max3f(a,p1[2],p1[3]);
  #pragma unroll
  for(int r=4;r<16;r+=4){a=max3f(a,p0[r],p0[r+1]);b=max3f(b,p0[r+2],p0[r+3]);a=max3f(a,p1[r],p1[r+1]);b=max3f(b,p1[r+2],p1[r+3]);}
  const float m=max2f(a,b);
  auto rr=__builtin_amdgcn_permlane32_swap(__float_as_uint(m),__float_as_uint(m),false,false);
  return max2f(__uint_as_float(rr[0]),__uint_as_float(rr[1]));
}
__device__ __forceinline__ void pv(f32x16*o,int vb,bf16x8 pa0,bf16x8 pa1,bf16x8 pa2,bf16x8 pa3){
  #pragma unroll
  for(int d0=0;d0<2;++d0){s16x4 lo[4],hi[4];
    #pragma unroll
    for(int ks=0;ks<4;++ks){
      asm volatile("ds_read_b64_tr_b16 %0,%1 offset:%c2":"=&v"(lo[ks]):"v"(vb),"i"(d0*4096+ks*1024):"memory");
      asm volatile("ds_read_b64_tr_b16 %0,%1 offset:%c2":"=&v"(hi[ks]):"v"(vb),"i"(d0*4096+ks*1024+512):"memory");}
    asm volatile("s_waitcnt lgkmcnt(0)":::"memory");SBAR();
    #define PK(k) (bf16x8){lo[k][0],lo[k][1],lo[k][2],lo[k][3],hi[k][0],hi[k][1],hi[k][2],hi[k][3]}
    o[d0]=__builtin_amdgcn_mfma_f32_32x32x16_bf16(pa0,PK(0),o[d0],0,0,0);
    o[d0]=__builtin_amdgcn_mfma_f32_32x32x16_bf16(pa1,PK(1),o[d0],0,0,0);
    o[d0]=__builtin_amdgcn_mfma_f32_32x32x16_bf16(pa2,PK(2),o[d0],0,0,0);
    o[d0]=__builtin_amdgcn_mfma_f32_32x32x16_bf16(pa3,PK(3),o[d0],0,0,0);
    #undef PK
  }
}

#ifndef ATTN_STORE16
#define ATTN_STORE16(p,v) (*(u32x4*)(p)=(v))
#endif
typedef float f32x4v __attribute__((ext_vector_type(4)));
__device__ __forceinline__ void attn_tables(int h,int qb,const float*__restrict__ TOT,float negTH,int ui,char*shm,int lane){
  typedef __attribute__((address_space(3))) float lds_f; typedef __attribute__((address_space(3))) int lds_i;
  const lds_cptr shmL=(lds_cptr)shm; lds_f* rtab=(lds_f*)(shmL+LDS_RT)+ui*256; lds_i* tsw=(lds_i*)(shmL+LDS_RT+8192);
  const int j0=4*qb; const float* tp=TOT+h*(SEQ/KVBLK); const int base=j0-1-4*lane;
  const float v0=base>=0?tp[base>=0?base:0]:0.f, v1=base-1>=0?tp[base-1>=0?base-1:0]:0.f, v2=base-2>=0?tp[base-2>=0?base-2:0]:0.f, v3=base-3>=0?tp[base-3>=0?base-3:0]:0.f;
  const float s0=v0,s1=s0+v1,s2=s1+v2,s3=s2+v3; float inc=s3;
  _Pragma("unroll") for(int o=1;o<64;o<<=1){const float y=__shfl_up(inc,o); if(lane>=o)inc+=y;}
  const float off=inc-s3; const float S0=off+s0,S1=off+s1,S2=off+s2,S3=off+s3;
  int cnt=((base>=0&&(S0-v0)>=negTH)?1:0)+((base-1>=0&&(S1-v1)>=negTH)?1:0)+((base-2>=0&&(S2-v2)>=negTH)?1:0)+((base-3>=0&&(S3-v3)>=negTH)?1:0);
  _Pragma("unroll") for(int o=1;o<64;o<<=1)cnt+=__shfl_xor(cnt,o);
  if(base>=0)rtab[base]=-S0; if(base-1>=0)rtab[base-1]=-S1; if(base-2>=0)rtab[base-2]=-S2; if(base-3>=0)rtab[base-3]=-S3;
  if(lane==0){const float a=tp[j0],b2=tp[j0+1],c=tp[j0+2]; rtab[j0]=0.f; rtab[j0+1]=a; rtab[j0+2]=a+b2; rtab[j0+3]=a+b2+c; tsw[ui]=(j0-cnt)&~1;}
}
__device__ __forceinline__ void attn_tables_fin(int qb,float v0,float v1,float v2,float v3,float a,float b2,float c,float negTH,int ui,char*shm,int lane){
  typedef __attribute__((address_space(3))) float lds_f; typedef __attribute__((address_space(3))) int lds_i;
  const lds_cptr shmL=(lds_cptr)shm; lds_f* rtab=(lds_f*)(shmL+LDS_RT)+ui*256; lds_i* tsw=(lds_i*)(shmL+LDS_RT+8192);
  const int j0=4*qb; const int base=j0-1-4*lane;
  const float s0=v0,s1=s0+v1,s2=s1+v2,s3=s2+v3; float inc=s3;
  _Pragma("unroll") for(int o=1;o<64;o<<=1){const float y=__shfl_up(inc,o); if(lane>=o)inc+=y;}
  const float off=inc-s3; const float S0=off+s0,S1=off+s1,S2=off+s2,S3=off+s3;
  int cnt=((base>=0&&(S0-v0)>=negTH)?1:0)+((base-1>=0&&(S1-v1)>=negTH)?1:0)+((base-2>=0&&(S2-v2)>=negTH)?1:0)+((base-3>=0&&(S3-v3)>=negTH)?1:0);
  _Pragma("unroll") for(int o=1;o<64;o<<=1)cnt+=__shfl_xor(cnt,o);
  if(base>=0)rtab[base]=-S0; if(base-1>=0)rtab[base-1]=-S1; if(base-2>=0)rtab[base-2]=-S2; if(base-3>=0)rtab[base-3]=-S3;
  if(lane==0){ rtab[j0]=0.f; rtab[j0+1]=a; rtab[j0+2]=a+b2; rtab[j0+3]=a+b2+c; tsw[ui]=(j0-cnt)&~1;}
}
__device__ __forceinline__ float bflo(unsigned w){return __uint_as_float(w<<16);} __device__ __forceinline__ float bfhi(unsigned w){return __uint_as_float(w&0xffff0000u);}
template<int THRL> __device__ __forceinline__ void attn_unit(int h,int qb,const bf16*Q,const bf16*__restrict__ K,const bf16*__restrict__ V,const bf16*__restrict__ SZ,bf16*O,const float*__restrict__ CL,int ui,unsigned*ctr,const float*__restrict__ TOT,float negTH,const __attribute__((address_space(3))) int*hor,char*shm){
  int tid_=threadIdx.x; asm volatile("":"+v"(tid_)); const int tid=tid_,lane=tid&63,r32=lane&31,hi=lane>>5; const int wid=__builtin_amdgcn_readfirstlane(tid>>6);
  const int q0=qb*QB;
  typedef __attribute__((address_space(3))) float lds_f; typedef __attribute__((address_space(3))) int lds_i;
  const lds_cptr shmL=(lds_cptr)shm;
  lds_f* c2l=(lds_f*)(shmL+LDS_C2); const lds_f* rtab=(const lds_f*)(shmL+LDS_RT)+ui*256; const lds_i* tsw=(const lds_i*)(shmL+LDS_RT+8192);
  const int ts=__builtin_amdgcn_readfirstlane(tsw[ui]);
  const lds_cptr c2p=shmL+LDS_C2+hi*16;
  const long rowbase=0;
  const bf16*Qw=Q+(long)(q0+wid*QBLK)*DM+h*D;
  const bf16*Kh=K+(long)ts*KVBLK*DM+h*D,*Vh=V+(long)ts*KVBLK*DM+h*D;
  #define INITLD(P0,P1,t) do{ const __attribute__((address_space(3))) f32x4v* cp_=(const __attribute__((address_space(3))) f32x4v*)(c2p+(t)*256); \
    _Pragma("unroll") for(int g_=0;g_<4;++g_){ const f32x4v a_=cp_[2*g_], b_=cp_[8+2*g_]; \
      P0[4*g_]=a_[0];P0[4*g_+1]=a_[1];P0[4*g_+2]=a_[2];P0[4*g_+3]=a_[3]; P1[4*g_]=b_[0];P1[4*g_+1]=b_[1];P1[4*g_+2]=b_[2];P1[4*g_+3]=b_[3]; } }while(0)
  #define INITSUB(P0,P1) do{ const float nm_=-mhat; _Pragma("unroll") for(int r=0;r<16;++r){P0[r]=nm_-P0[r];P1[r]=nm_-P1[r];} }while(0)
  #define CBIAS(P0,P1,t) do{ const __attribute__((address_space(3))) f32x4v* cp_=(const __attribute__((address_space(3))) f32x4v*)(c2p+(t)*256); \
    _Pragma("unroll") for(int g_=0;g_<4;++g_){ const f32x4v a_=cp_[2*g_], b_=cp_[8+2*g_]; \
      P0[4*g_]-=a_[0];P0[4*g_+1]-=a_[1];P0[4*g_+2]-=a_[2];P0[4*g_+3]-=a_[3]; P1[4*g_]-=b_[0];P1[4*g_+1]-=b_[1];P1[4*g_+2]-=b_[2];P1[4*g_+3]-=b_[3]; SBAR(); } }while(0)
  const unsigned lds0=(unsigned)(uintptr_t)shm;
  float*wsf=(float*)(shm+LDS_WS)+wid*64;
  const bf16*ksrc=Kh+(long)lane*DM+wid*8;
  const bf16*vsrc=Vh+(long)(16*(wid&3)+(lane>>2))*DM+(wid>>2)*32+(lane&3)*8;
  const unsigned kdst=lds0+LDS_K+wid*1024, vdst=lds0+LDS_V+wid*1024;
  #define DMA_K(t,slot) glds16(ksrc+(long)(t)*KVBLK*DM,(unsigned)__builtin_amdgcn_readfirstlane(kdst+(slot)))
  #define DMA_V(t,slot) glds16(vsrc+(long)(t)*KVBLK*DM,(unsigned)__builtin_amdgcn_readfirstlane(vdst+(slot)))
  const int vb0=(int)(lds0+LDS_V)+((lane>>4)&1)*32+(lane&3)*8+(4*hi+((lane&15)>>2))*64;
  const char*Kbase=shm+LDS_K; bf16x8 kf[8];
  const lds_cptr shm3=(lds_cptr)shm; const lds_cptr kp0=shm3+LDS_K+hi*1024+r32*16; const lds_cptr vp0=shm3+LDS_V+((lane>>4)&1)*32+(lane&3)*8+(4*hi+((lane&15)>>2))*64;
  const int NT=(q0+QB)/KVBLK-ts;
  DMA_K(0,0);DMA_V(0,0);DMA_K(1,SLOTB);
  bf16x8 qr[4];
  #pragma unroll
  for(int d0=0;d0<4;++d0)qr[d0]=*reinterpret_cast<const bf16x8*>(&Qw[(long)r32*DM+d0*16+hi*8]);
  float mhat=0.f,l_reg=0.f;f32x16 o[2];o[0]=f32x16{};o[1]=f32x16{};const f32x16 zero16=f32x16{};
  const int qrel=wid*QBLK+r32;
  #define CMASK(P0,P1,t) do{int jb_=(t)-(NT-4); if(jb_>=0)cmask(P0,P1,jb_,qrel,hi);}while(0)
  bool resc=false;
  #define START(P0,P1) do{ const float rm=rowmax(P0,P1); resc=false; \
    { const float dl=rm; mhat=fadd_s(mhat,dl); \
      _Pragma("unroll") for(int r=0;r<16;++r){P0[r]=fsub_s(P0[r],dl);P1[r]=fsub_s(P1[r],dl);} \
      } \
    _Pragma("unroll") for(int r=0;r<16;++r)P0[r]=__builtin_amdgcn_exp2f(P0[r]); }while(0)
  #define RESC() do{ if(resc){ asm volatile("s_waitcnt lgkmcnt(0)":::"memory"); \
      _Pragma("unroll") for(int d_=0;d_<2;++d_) _Pragma("unroll") for(int r=0;r<16;++r)o[d_][r]*=wsf[crow(r,hi)]; } }while(0)
  f32x16 pA0,pA1,pB0,pB1;
  int sl_prev=0,sl_cur=0,sl_next=SLOTB;
  #define ROT() do{sl_prev=sl_cur;sl_cur=sl_next;sl_next=(sl_next==(NSLOT-1)*SLOTB)?0:sl_next+SLOTB;}while(0)
  DMA_K(2,2*SLOTB);
  { const float* clp=CL+(long)h*SEQ+ts*KVBLK; const int n=(q0+QB)-ts*KVBLK;
    for(int i0=tid;i0<n;i0+=4*NW*64){ float cv[4];
      _Pragma("unroll") for(int j=0;j<4;++j){ const int i=i0+j*NW*64; cv[j]=clp[i<n?i:0]; }
      _Pragma("unroll") for(int j=0;j<4;++j){ const int i=i0+j*NW*64; if(i<n) c2l[i]=(cv[j]+rtab[(ts*KVBLK+i)>>6])*1.4426950408889634f; } } }
  unsigned nraw=0u; if(wid==0&&lane==0)nraw=__hip_atomic_fetch_add(ctr,1u,__ATOMIC_RELAXED,__HIP_MEMORY_SCOPE_AGENT);
  WAIT_BAR(3);
  qkt(pA0,pA1,Kbase,qr,zero16,r32,hi);asm volatile("s_nop 15\n\ts_nop 7":"+v"(pA0),"+v"(pA1));CBIAS(pA0,pA1,0);CMASK(pA0,pA1,0);
  START(pA0,pA1);
  _Pragma("unroll") for(int r=0;r<16;++r)pA1[r]=__builtin_amdgcn_exp2f(pA1[r]);
  INITLD(pB0,pB1,1); INITSUB(pB0,pB1);
  WAIT_BAR(0);
  DMA_K(3,0);DMA_V(1,SLOTB);
  ROT();
  kload8(kf,kp0+sl_cur);
  WAIT_BAR(2);
  s16x4 vlo[8],vhi[8]; u32x4 pw0,pw1,pw2,pw3;
  #define PKW(P,B) cvtpk_s(P[B],P[B+1])
  #define PAF(k) __builtin_bit_cast(bf16x8,pw##k)
  #define VFR(i) (bf16x8){vlo[i][0],vlo[i][1],vlo[i][2],vlo[i][3],vhi[i][0],vhi[i][1],vhi[i][2],vhi[i][3]}
  #define PIN(x) asm volatile("":"+v"(x))
  #define MX3(a,b,c) __builtin_fmaxf(__builtin_fmaxf((a),(b)),(c))
  #define GAPA(MF,A0,A1,A2,A3,W0,W1,PW) do{ MF; sacc+=A0; sacc+=A1; sacc+=A2; sacc+=A3; PIN(sacc); W0; W1; PIN(PW); SBAR(); }while(0)
  #define EX(v) __builtin_amdgcn_exp2f(v)
  #define GAPB(MF,X,B) do{ MF; X[B]=EX(X[B]); X[B+1]=EX(X[B+1]); X[B+2]=EX(X[B+2]); X[B+3]=EX(X[B+3]); PIN(X); SBAR(); }while(0)
  #define VRD(i) do{ vlo[i]=vtr(vp_+(((i)>>2)*4096+((i)&3)*1024)); vhi[i]=vtr(vp_+(((i)>>2)*4096+((i)&3)*1024+512)); }while(0)
  #define KRD(G,j) do{ if(G){ kload2(kf,kp0+sl_next,j); SBAR(); } }while(0)
  #define STEP(C0,C1,P0,P1,t,GK,GV,GL,ZL) do{ SBAR(); \
    const lds_cptr vp_=vp0+sl_prev; \
    VRD(0); SBAR(); float sacc=(P0[0]+P0[1]); \
    GAPA(C0=__builtin_amdgcn_mfma_f32_32x32x16_bf16(kf[0],qr[0],C0,0,0,0), P0[2],P0[3],P0[4],P0[5],     pw0[0]=PKW(P0,0), pw0[1]=PKW(P0,2), pw0); \
    VRD(4); SBAR(); GAPA(C1=__builtin_amdgcn_mfma_f32_32x32x16_bf16(kf[1],qr[0],C1,0,0,0), P0[6],P0[7],P0[8],P0[9],     pw0[2]=PKW(P0,4), pw0[3]=PKW(P0,6), pw0); \
    VRD(1); SBAR(); GAPA(C0=__builtin_amdgcn_mfma_f32_32x32x16_bf16(kf[2],qr[1],C0,0,0,0),   P0[10],P0[11],P0[12],P0[13], pw1[0]=PKW(P0,8), pw1[1]=PKW(P0,10), pw1); \
    VRD(5); SBAR(); GAPA(C1=__builtin_amdgcn_mfma_f32_32x32x16_bf16(kf[3],qr[1],C1,0,0,0),   P0[14],P0[15],P1[0],P1[1],   pw1[2]=PKW(P0,12),pw1[3]=PKW(P0,14), pw1); \
    VRD(2); SBAR(); GAPA(C0=__builtin_amdgcn_mfma_f32_32x32x16_bf16(kf[4],qr[2],C0,0,0,0),   P1[2],P1[3],P1[4],P1[5],     pw2[0]=PKW(P1,0), pw2[1]=PKW(P1,2), pw2); \
    VRD(6); SBAR(); GAPA(C1=__builtin_amdgcn_mfma_f32_32x32x16_bf16(kf[5],qr[2],C1,0,0,0),   P1[6],P1[7],P1[8],P1[9],     pw2[2]=PKW(P1,4), pw2[3]=PKW(P1,6), pw2); \
    VRD(3); SBAR(); GAPA(C0=__builtin_amdgcn_mfma_f32_32x32x16_bf16(kf[6],qr[3],C0,0,0,0),   P1[10],P1[11],P1[12],P1[13], pw3[0]=PKW(P1,8), pw3[1]=PKW(P1,10), pw3); \
    VRD(7); SBAR(); GAPA(C1=__builtin_amdgcn_mfma_f32_32x32x16_bf16(kf[7],qr[3],C1,0,0,0),   P1[14],P1[15],0.f,0.f,       pw3[2]=PKW(P1,12),pw3[3]=PKW(P1,14), pw3); \
    l_reg+=sacc; \
    if(GK){DMA_K((t)+3,sl_cur);} if(GV){DMA_V((t)+1,sl_next);} \
    CMASK(C0,C1,t); \
    { float a=MX3(C0[0],C0[1],C1[0]),b=MX3(C0[2],C0[3],C1[1]); a=MX3(a,C1[2],C1[3]); \
      _Pragma("unroll") for(int r=4;r<16;r+=4){a=MX3(a,C0[r],C0[r+1]);b=MX3(b,C0[r+2],C0[r+3]);a=MX3(a,C1[r],C1[r+1]);b=MX3(b,C1[r+2],C1[r+3]);} \
      float rm=__builtin_fmaxf(a,b); { auto rr=__builtin_amdgcn_permlane32_swap(__float_as_uint(rm),__float_as_uint(rm),false,false); rm=__builtin_fmaxf(__uint_as_float(rr[0]),__uint_as_float(rr[1])); } \
      resc=false; \
      if(__builtin_expect(__any(rm>(float)THRL),0)){ const float dl=__builtin_fmaxf(rm,0.f); mhat+=dl; \
        _Pragma("unroll") for(int r=0;r<16;++r){C0[r]-=dl;C1[r]-=dl;} \
        const float f=__builtin_amdgcn_exp2f(-dl); l_reg*=f; if(hi==0)wsf[r32]=f; resc=true; } } \
    SBAR(); \
    if(GL){INITLD(P0,P1,(t)+1);} if(ZL){ _Pragma("unroll") for(int i_=0;i_<4;++i_) zg[i_]=*(const u32x4*)(Zw+(long)(i_*8)*DM); } SBAR(); \
    GAPB(o[0]=__builtin_amdgcn_mfma_f32_32x32x16_bf16(PAF(0),VFR(0),o[0],0,0,0), C0,0); \
    GAPB(o[1]=__builtin_amdgcn_mfma_f32_32x32x16_bf16(PAF(0),VFR(4),o[1],0,0,0), C0,4); \
    KRD(GL,0); GAPB(o[0]=__builtin_amdgcn_mfma_f32_32x32x16_bf16(PAF(1),VFR(1),o[0],0,0,0), C0,8); \
    KRD(GL,1); GAPB(o[1]=__builtin_amdgcn_mfma_f32_32x32x16_bf16(PAF(1),VFR(5),o[1],0,0,0), C0,12); \
    KRD(GL,2); GAPB(o[0]=__builtin_amdgcn_mfma_f32_32x32x16_bf16(PAF(2),VFR(2),o[0],0,0,0), C1,0); \
    KRD(GL,3); GAPB(o[1]=__builtin_amdgcn_mfma_f32_32x32x16_bf16(PAF(2),VFR(6),o[1],0,0,0), C1,4); \
    GAPB(o[0]=__builtin_amdgcn_mfma_f32_32x32x16_bf16(PAF(3),VFR(3),o[0],0,0,0), C1,8); \
    GAPB(o[1]=__builtin_amdgcn_mfma_f32_32x32x16_bf16(PAF(3),VFR(7),o[1],0,0,0), C1,12); \
    if(GL){INITSUB(P0,P1);} \
    }while(0)
  u32x4 zg[4]; const bf16*Zw=nullptr;
  int t=1;
  #undef CMASK
  #define CMASK(P0,P1,t) do{}while(0)
  for(;t+5<NT;t+=2){
    STEP(pB0,pB1,pA0,pA1,t,true,true,true,false);     WAIT_BAR(2); RESC(); ROT();
    STEP(pA0,pA1,pB0,pB1,t+1,true,true,true,false);   WAIT_BAR(2); RESC(); ROT();
  }
  #undef CMASK
  #define CMASK(P0,P1,t) do{int jb_=(t)-(NT-4); if(jb_>=0)cmask(P0,P1,jb_,qrel,hi);}while(0)
  #define ENDW(tt) do{ if((tt)+3<NT){WAIT_BAR(2);} else if((tt)+2<NT){WAIT_BAR(1);} else {WAIT_BAR(0);} }while(0)
  for(;t+1<NT;t+=2){
    STEP(pB0,pB1,pA0,pA1,t,(t+3<NT),(t+1<NT),(t+1<NT),false);       ENDW(t);   RESC(); ROT();
    STEP(pA0,pA1,pB0,pB1,t+1,(t+4<NT),(t+2<NT),(t+2<NT),false);     ENDW(t+1); RESC(); ROT();
  }
  int lane_e=lane; asm volatile("":"+v"(lane_e)); const long eoff=(long)(lane_e>>3)*DM+(lane_e&7)*8;
  Zw=SZ+(rowbase+q0+wid*QBLK)*DM+h*D+eoff;
  STEP(pB0,pB1,pA0,pA1,NT-1,false,false,false,true); RESC();
  int nxt_=NUNITS,qbn_=0; float tv0=0.f,tv1=0.f,tv2=0.f,tv3=0.f,ta=0.f,tb=0.f,tc=0.f;
  if(wid==0){ nxt_=__builtin_amdgcn_readfirstlane((int)nraw);
    if(nxt_<NUNITS){ const int hn_=__builtin_amdgcn_readfirstlane(hor[nxt_>>6]); qbn_=(NQB-1)-(nxt_&(NQB-1));
      const float* tp=TOT+hn_*(SEQ/KVBLK); const int j0n=4*qbn_, base=j0n-1-4*lane;
      tv0=base>=0?tp[base>=0?base:0]:0.f; tv1=base-1>=0?tp[base-1>=0?base-1:0]:0.f; tv2=base-2>=0?tp[base-2>=0?base-2:0]:0.f; tv3=base-3>=0?tp[base-3>=0?base-3:0]:0.f;
      ta=tp[j0n]; tb=tp[j0n+1]; tc=tp[j0n+2]; } }
  { float sacc=pB0[0]+pB0[1]; _Pragma("unroll") for(int r=2;r<16;++r)sacc+=pB0[r]; _Pragma("unroll") for(int r=0;r<16;++r)sacc+=pB1[r]; l_reg+=sacc;
    pw0=(u32x4){PKW(pB0,0),PKW(pB0,2),PKW(pB0,4),PKW(pB0,6)};pw1=(u32x4){PKW(pB0,8),PKW(pB0,10),PKW(pB0,12),PKW(pB0,14)};pw2=(u32x4){PKW(pB1,0),PKW(pB1,2),PKW(pB1,4),PKW(pB1,6)};pw3=(u32x4){PKW(pB1,8),PKW(pB1,10),PKW(pB1,12),PKW(pB1,14)};
    SBAR(); pv(o,vb0+sl_cur,PAF(0),PAF(1),PAF(2),PAF(3)); }
  #undef PKW
  #undef PAF
  #undef VFR
  #undef PIN
  #undef MX3
  #undef GAPA
  #undef GAPB
  #undef EX
  #undef VRD
  #undef KRD
  #undef STEP
  #undef ENDW
  {auto rr=__builtin_amdgcn_permlane32_swap(__float_as_uint(l_reg),__float_as_uint(l_reg),false,false);l_reg=__uint_as_float(rr[0])+__uint_as_float(rr[1]);}
  if(hi==0)wsf[32+r32]=l_reg;asm volatile("s_waitcnt lgkmcnt(0)":::"memory");
  float rli[16];
  #pragma unroll
  for(int r=0;r<16;++r)rli[r]=__builtin_amdgcn_rcpf(wsf[32+crow(r,hi)]);
  bf16*Ow=O+(rowbase+q0+wid*QBLK)*DM+h*D+eoff;
  { bf16*stg=(bf16*)(shm+LDS_OST)+wid*2048;
    #pragma unroll
    for(int r=0;r<16;++r){const int orow=crow(r,hi);
      #pragma unroll
      for(int d0=0;d0<2;++d0)stg[orow*64+d0*32+r32]=__float2bfloat16(o[d0][r]*rli[r]);}
    asm volatile("s_waitcnt lgkmcnt(0)":::"memory");
    #pragma unroll
    for(int i=0;i<4;++i){const int row=i*8+(lane_e>>3),ch=lane_e&7; const u32x4 v=*(const u32x4*)(stg+row*64+ch*8); u32x4 w;
      _Pragma("unroll") for(int c=0;c<4;++c)w[c]=cvtpk_s(bflo(v[c])*bflo(zg[i][c]),bfhi(v[c])*bfhi(zg[i][c]));
      ATTN_STORE16(Ow+(long)(i*8)*DM,w);} }
  if(wid==0){ const int ns=ui^1;
    if(nxt_<NUNITS){ attn_tables_fin(qbn_,tv0,tv1,tv2,tv3,ta,tb,tc,negTH,ns,shm,lane); }
    if(lane==0)((__attribute__((address_space(3))) int*)((lds_cptr)shm+LDS_RT+8192+32))[ns]=nxt_; }
  asm volatile("s_waitcnt lgkmcnt(0)\n\ts_barrier":::"memory");
  #undef CBIAS
  #undef INITLD
  #undef INITSUB
  #undef DMA_K
  #undef DMA_V
  #undef CMASK
  #undef START
  #undef RESC
  #undef ROT
}
constexpr int ATTN_LDS_BYTES=LDS_ALL;
#undef SBAR
#undef WAIT_BAR
}
constexpr int NWAVES = 8;
constexpr int SEQ = 16384, D = 1024, H = 16, HD = 64, NIN = 4 * D, LDW3 = 4 * D + H;
constexpr float RMS_EPS = 1e-6f;
constexpr size_t MiB = 1u << 20;
constexpr size_t WS_CTL = 0, CTL_ZERO_BYTES = 16384; constexpr int CW_QUEUE = 3584;
constexpr size_t WS_W1 = 2 * MiB, WS_W2 = 10 * MiB, WS_W3 = 12 * MiB, WS_W4 = 20 * MiB, WS_WF = 22 * MiB, WS_SSQ = 23 * MiB, WS_CL = 24 * MiB, WS_TOT = 25 * MiB, WS_RMS0 = 25 * MiB + 512 * 1024, WS_HU = 26 * MiB, WS_HG = 27 * MiB, WS_TU = 28 * MiB;
constexpr size_t WS_XN = 32 * MiB, WS_U = 64 * MiB  , WS_GZ = 96 * MiB  , WS_Y = 128 * MiB, WS_X1B = 160 * MiB, WS_Q = 192 * MiB, WS_K = 224 * MiB, WS_END = 256 * MiB;
constexpr size_t WS_V = WS_U, WS_SZ = WS_GZ, WS_OG = WS_Y;
constexpr int RING_OFF = 0, RING_BYTES = 131072;
constexpr int LDS_BYTES = 160 * 1024;
static_assert(attn_body::ATTN_LDS_BYTES + 256 <= LDS_BYTES, "LDS map");
constexpr int HOR_OFF = attn_body::ATTN_LDS_BYTES;

#define GAS __attribute__((address_space(1)))
#define LAS __attribute__((address_space(3)))
typedef unsigned short bf16;
typedef unsigned v4u __attribute__((ext_vector_type(4)));
typedef float f32x4 __attribute__((ext_vector_type(4)));
typedef short bf16x8 __attribute__((ext_vector_type(8)));
#define LDS_WAIT() asm volatile("s_waitcnt lgkmcnt(0)" ::: "memory")
__device__ __forceinline__ unsigned f2bf(float f) { unsigned u = __builtin_bit_cast(unsigned, f); return (u + 0x7fffu + ((u >> 16) & 1u)) >> 16; }
__device__ __forceinline__ unsigned pk2(float lo, float hi) { return f2bf(lo) | (f2bf(hi) << 16); }
__device__ __forceinline__ float wave_sum(float v) {
#pragma unroll
    for (int o = 1; o < 64; o <<= 1) v += __shfl_xor(v, o);
    return v;
}
template <int MAP> __device__ __forceinline__ int colmap(int s) {
    if (MAP == 1) { const int mat = s >> 10, d = s & 1023; return 256 * (d >> 6) + 128 * (mat >> 1) + 32 * ((d >> 4) & 3) + 8 * ((d >> 2) & 3) + 4 * (mat & 1) + (d & 3); }
    if (MAP == 2) { return (s & ~255) + 128 * ((s >> 5) & 1) + 32 * ((s >> 6) & 3) + (s & 31); }
    return s;
}
template <int MAP> __device__ __forceinline__ void p0_transpose_item(const float* W, int K, int ldw, int N, const float* gk, bf16* WT, LAS float* scr, int item, int lane) {
    const int nblk = N / 32, kb = item / nblk, nb = item % nblk, k0 = 64 * kb, n0 = 32 * nb;
    { f32x4 w[8]; const int c4 = lane & 7, kr = lane >> 3;
#pragma unroll
      for (int i = 0; i < 8; ++i) w[i] = __builtin_nontemporal_load((const GAS f32x4*)(W + (size_t)(k0 + kr + 8 * i) * ldw + n0 + 4 * c4));
#pragma unroll
      for (int i = 0; i < 8; ++i) { const int kk = kr + 8 * i; f32x4 v = w[i]; if (gk) v = v * gk[k0 + kk];
          LAS float* d = scr + kk * 33 + 4 * c4; d[0] = v.x; d[1] = v.y; d[2] = v.z; d[3] = v.w; } }
    LDS_WAIT(); asm volatile("" ::: "memory");
    const int c = lane & 7;
#pragma unroll
    for (int j = 0; j < 4; ++j) { const int n = (lane >> 3) + 8 * j; const LAS float* s = scr + (8 * c) * 33 + n;
        v4u o; o.x = pk2(s[0 * 33], s[1 * 33]); o.y = pk2(s[2 * 33], s[3 * 33]); o.z = pk2(s[4 * 33], s[5 * 33]); o.w = pk2(s[6 * 33], s[7 * 33]);
        *(GAS v4u*)(WT + (size_t)colmap<MAP>(n0 + n) * K + k0 + 8 * c) = o; }
    LDS_WAIT(); asm volatile("" ::: "memory");
}
__device__ __forceinline__ void rms_row_to_bf16(const float* xrow, const float* g, bf16* orow, int lane) {
    const GAS f32x4* xr = (const GAS f32x4*)xrow + lane; const GAS f32x4* gr = (const GAS f32x4*)g + lane;
    f32x4 v[4]; float s = 0.f;
#pragma unroll
    for (int j = 0; j < 4; ++j) { v[j] = xr[64 * j]; s += (v[j].x * v[j].x + v[j].y * v[j].y) + (v[j].z * v[j].z + v[j].w * v[j].w); }
    const float inv = 1.f / sqrtf(wave_sum(s) * (1.f / D) + RMS_EPS);
    GAS unsigned long long* o8 = (GAS unsigned long long*)orow + lane;
#pragma unroll
    for (int j = 0; j < 4; ++j) { const f32x4 gg = gr[64 * j]; const f32x4 y = v[j] * inv * gg; o8[64 * j] = (unsigned long long)pk2(y.x, y.y) | ((unsigned long long)pk2(y.z, y.w) << 32); }
}
__device__ __forceinline__ void rms_4rows_to_bf16(const float* x0, const float* g, bf16* o0, size_t stride, int lane, float* rms_out, int rstride) {
    const GAS f32x4* gr = (const GAS f32x4*)g + lane;
    f32x4 v[4][4]; float s[4];
#pragma unroll
    for (int r = 0; r < 4; ++r)
#pragma unroll
        for (int j = 0; j < 4; ++j) v[r][j] = __builtin_nontemporal_load((const GAS f32x4*)(x0 + r * stride) + lane + 64 * j);
#pragma unroll
    for (int r = 0; r < 4; ++r) { float a = 0.f;
#pragma unroll
        for (int j = 0; j < 4; ++j) a += (v[r][j].x * v[r][j].x + v[r][j].y * v[r][j].y) + (v[r][j].z * v[r][j].z + v[r][j].w * v[r][j].w);
        const float ms = wave_sum(a) * (1.f / D) + RMS_EPS; s[r] = 1.f / sqrtf(ms); if (lane == 0) rms_out[r * rstride] = sqrtf(ms); }
#pragma unroll
    for (int j = 0; j < 4; ++j) { const f32x4 gg = gr[64 * j];
#pragma unroll
        for (int r = 0; r < 4; ++r) { const f32x4 y = v[r][j] * s[r] * gg; ((GAS unsigned long long*)(o0 + r * stride) + lane)[64 * j] = (unsigned long long)pk2(y.x, y.y) | ((unsigned long long)pk2(y.z, y.w) << 32); } }
}
__device__ __forceinline__ void rms_2rows_to_bf16(const float* xa, const float* xb, const float* g, bf16* oa, bf16* ob, int lane) {
    const GAS f32x4* ra = (const GAS f32x4*)xa + lane; const GAS f32x4* rb = (const GAS f32x4*)xb + lane; const GAS f32x4* gr = (const GAS f32x4*)g + lane;
    f32x4 va[4], vb[4]; float sa = 0.f, sb = 0.f;
#pragma unroll
    for (int j = 0; j < 4; ++j) { va[j] = ra[64 * j]; vb[j] = rb[64 * j]; }
#pragma unroll
    for (int j = 0; j < 4; ++j) { sa += (va[j].x * va[j].x + va[j].y * va[j].y) + (va[j].z * va[j].z + va[j].w * va[j].w); sb += (vb[j].x * vb[j].x + vb[j].y * vb[j].y) + (vb[j].z * vb[j].z + vb[j].w * vb[j].w); }
    const float ia = 1.f / sqrtf(wave_sum(sa) * (1.f / D) + RMS_EPS), ib = 1.f / sqrtf(wave_sum(sb) * (1.f / D) + RMS_EPS);
    GAS unsigned long long* o8a = (GAS unsigned long long*)oa + lane; GAS unsigned long long* o8b = (GAS unsigned long long*)ob + lane;
#pragma unroll
    for (int j = 0; j < 4; ++j) { const f32x4 gg = gr[64 * j]; const f32x4 ya = va[j] * ia * gg, yb = vb[j] * ib * gg;
        o8a[64 * j] = (unsigned long long)pk2(ya.x, ya.y) | ((unsigned long long)pk2(ya.z, ya.w) << 32); o8b[64 * j] = (unsigned long long)pk2(yb.x, yb.y) | ((unsigned long long)pk2(yb.z, yb.w) << 32); }
}
__device__ __forceinline__ float bf_lo(unsigned w) { return __uint_as_float(w << 16); }
__device__ __forceinline__ float bf_hi(unsigned w) { return __uint_as_float(w & 0xffff0000u); }

typedef GAS unsigned gu32;
#define RLX_AGENT __ATOMIC_RELAXED, __HIP_MEMORY_SCOPE_AGENT
#define XB_TMO      128
#define XB_XCNT(j)  (256  + 64 * (j))
#define XB_XSUB(j)  (1280 + 64 * (j))
#define XB_XGEN(j)  (2304 + 64 * (j))
#define XB_TOP      3328
#define XB_TOPGEN   3392
#define XCD_BAR_WORDS 3456
#define XB_SPIN_CAP (1u << 18)

__device__ __forceinline__ unsigned xb_ld(unsigned* p)              { return __hip_atomic_load(p, __ATOMIC_RELAXED, __HIP_MEMORY_SCOPE_AGENT); }
__device__ __forceinline__ unsigned xb_add(unsigned* p, unsigned v) { return __hip_atomic_fetch_add(p, v, __ATOMIC_RELAXED, __HIP_MEMORY_SCOPE_AGENT); }
__device__ __forceinline__ unsigned xb_xcc_id() { return (unsigned)__builtin_amdgcn_s_getreg((3 << 11) | 20) & 0xFu; }
#define XB_SPIN(cond, bar) do { unsigned _sp = 0; while (cond) { __builtin_amdgcn_s_sleep(1); \
    if ((++_sp & 255u) == 0u) { if (xb_ld(&(bar)[XB_TMO])) break; if (_sp > XB_SPIN_CAP) { atomicAdd(&(bar)[XB_TMO], 1u); break; } } } } while (0)

struct XcdBarrier {
    unsigned* bar; unsigned x;
    volatile LAS unsigned* st;
};

__device__ __forceinline__ XcdBarrier xcd_barrier_post(unsigned* bar, volatile LAS unsigned* st) {
    XcdBarrier b; b.bar = bar; b.x = xb_xcc_id(); b.st = st;
    if (threadIdx.x == 0) (void)xb_add(&bar[XB_XCNT(b.x)], 1u);
    return b;
}
__device__ __forceinline__ void xcd_barrier_complete(unsigned* bar, unsigned x, unsigned& nloc, unsigned& nx) {
    const unsigned G = gridDim.x * gridDim.y * gridDim.z;
    unsigned sum, cnt, mine, sp = 0u;
    for (;;) {
        sum = 0u; cnt = 0u; mine = 0u;
#pragma unroll
        for (unsigned j = 0; j < 16; ++j) { const unsigned c = xb_ld(&bar[XB_XCNT(j)]); sum += c; cnt += (c > 0u) ? 1u : 0u; mine = (j == x) ? c : mine; }
        if (sum == G) break;
        __builtin_amdgcn_s_sleep(1);
        if ((++sp & 255u) == 0u) { if (xb_ld(&bar[XB_TMO])) break; if (sp > XB_SPIN_CAP) { atomicAdd(&bar[XB_TMO], 1u); break; } }
    }
    nloc = mine > 0u ? mine : 1u; nx = cnt > 0u ? cnt : 1u;
}

__device__ __forceinline__ void xcd_barrier(const XcdBarrier& b) {
    asm volatile("s_waitcnt vmcnt(0)" ::: "memory");
    __syncthreads();
    if (threadIdx.x == 0) {
        unsigned* bar = b.bar;
        __builtin_amdgcn_s_waitcnt(0);
        unsigned nloc = b.st[0], nx = b.st[1];
        if (nloc == 0u) { xcd_barrier_complete(bar, b.x, nloc, nx); b.st[0] = nloc; b.st[1] = nx; }
        const unsigned old = xb_add(&bar[XB_XSUB(b.x)], 1u);
        const unsigned gen = old / nloc;
        if (old + 1u == (gen + 1u) * nloc) {
            __builtin_amdgcn_fence(__ATOMIC_RELEASE, "agent");
            asm volatile("s_waitcnt vmcnt(0)" ::: "memory");
            const unsigned og = xb_add(&bar[XB_TOP], 1u);
            const unsigned tg = og / nx;
            if (og + 1u == (tg + 1u) * nx) xb_add(&bar[XB_TOPGEN], 1u);
            else XB_SPIN(xb_ld(&bar[XB_TOPGEN]) == tg, bar);
            __builtin_amdgcn_fence(__ATOMIC_ACQUIRE, "agent");
            xb_add(&bar[XB_XGEN(b.x)], 1u);
            asm volatile("s_waitcnt vmcnt(0)" ::: "memory");
        } else {
            XB_SPIN(xb_ld(&bar[XB_XGEN(b.x)]) == gen, bar);
            __builtin_amdgcn_fence(__ATOMIC_ACQUIRE, "agent");
            asm volatile("s_waitcnt vmcnt(0)" ::: "memory");
        }
    }
    __syncthreads();
}

struct Args { const float* in[11]; float* out; unsigned char* ws; int cg_seams; int pad; };

__global__ void __launch_bounds__(NWAVES * 64, 2) fwd_megakernel(Args args) {
    extern __shared__ __attribute__((aligned(16))) unsigned char lds[];
    cg::grid_group grid = cg::this_grid();
    LAS unsigned char* ldsL = (LAS unsigned char*)lds;
    const int tid = threadIdx.x, lane = tid & 63, wave = __builtin_amdgcn_readfirstlane(tid >> 6);
    const int G = gridDim.x; const int bx = blockIdx.x; const int vcu = (G % 8 == 0) ? (bx % 8) * (G / 8) + bx / 8 : bx;
    unsigned char* ws = args.ws;
    const float* x = args.in[0]; const float* conv_norm_g = args.in[1]; const float* conv_w_in = args.in[2]; const float* conv_w = args.in[3]; const float* conv_w_out = args.in[4];
    const float* attn_norm_g = args.in[5]; const float* attn_w_in = args.in[6]; const float* attn_b_f = args.in[7]; const float* q_g = args.in[8]; const float* k_g = args.in[9]; const float* attn_w_out = args.in[10];
    float* out = args.out;
    bf16 *W1t = (bf16*)(ws + WS_W1), *W2t = (bf16*)(ws + WS_W2), *W3t = (bf16*)(ws + WS_W3), *W4t = (bf16*)(ws + WS_W4), *Wft = (bf16*)(ws + WS_WF);
    float *SSQ = (float*)(ws + WS_SSQ), *CL = (float*)(ws + WS_CL), *TOT = (float*)(ws + WS_TOT);
    bf16 *XN = (bf16*)(ws + WS_XN), *Y = (bf16*)(ws + WS_Y), *X1B = (bf16*)(ws + WS_X1B);
    float *RMS0 = (float*)(ws + WS_RMS0);
    float *HU = (float*)(ws + WS_HU), *HG = (float*)(ws + WS_HG), *TU = (float*)(ws + WS_TU);
    bf16 *Qb = (bf16*)(ws + WS_Q), *Kb = (bf16*)(ws + WS_K), *Vb = (bf16*)(ws + WS_V), *SZ = (bf16*)(ws + WS_SZ), *OG = (bf16*)(ws + WS_OG);

    volatile LAS unsigned* MISC = (volatile LAS unsigned*)(ldsL + LDS_BYTES - 64);
    if (tid == 0) { MISC[0] = 0u; MISC[1] = 0u; }
    __syncthreads();
    const XcdBarrier bar = xcd_barrier_post((unsigned*)(ws + WS_CTL), MISC);
    {
        LAS float* scr = (LAS float*)(ldsL + RING_OFF + wave * 16384);
        const int gw = vcu * NWAVES + wave, NGW = G * NWAVES;
        constexpr int I1 = (D / 64) * (NIN / 32), I2 = (D / 64) * (D / 32), I3 = I1, I4 = I2, NITEMS = I1 + I2 + I3 + I4;
        for (int it = gw; it < NITEMS; it += NGW) {
            int r = it;
            if (r < I1) { p0_transpose_item<1>(conv_w_in, D, NIN, NIN, nullptr, W1t, scr, r, lane); continue; } r -= I1;
            if (r < I2) { p0_transpose_item<0>(conv_w_out, D, D, D, nullptr, W2t, scr, r, lane); continue; } r -= I2;
            if (r < I3) { p0_transpose_item<2>(attn_w_in, D, LDW3, NIN, attn_norm_g, W3t, scr, r, lane); continue; } r -= I3;
            p0_transpose_item<0>(attn_w_out, D, D, D, nullptr, W4t, scr, r, lane);
        }
        for (int i = gw * 64 + lane; i < H * D; i += NGW * 64) { const int h = i >> 10, k = i & 1023; Wft[i] = (bf16)f2bf(attn_w_in[(size_t)k * LDW3 + NIN + h] * attn_norm_g[k]); }
        for (int m = gw; m < SEQ; m += 4 * NGW) rms_4rows_to_bf16(x + (size_t)m * D, conv_norm_g, XN + (size_t)m * D, (size_t)NGW * D, lane, RMS0 + m, NGW);
    }
    if (args.cg_seams) grid.sync(); else xcd_barrier(bar);

    {
        pg8::Gemm g{XN, W1t, SEQ, NIN, D}; pg8::StaticOrder S; S.init(SEQ, NIN, G, bx);
        pg8::EpiConvIn E{Y, HU, HG, TU, conv_w, (LAS float*)(ldsL + RING_BYTES)};
        pg8::gemm_phase<pg8::EpiConvIn, pg8::StaticOrder, true, true>(ldsL + RING_OFF, g, S, E);
    }
    if (args.cg_seams) grid.sync(); else xcd_barrier(bar);

    {
        pg8::Gemm g{Y, W2t, SEQ, D, D}; pg8::StaticOrder S; S.init(SEQ, D, G, bx);
        { pg8::Unit pu; for (int i = 0; S.next(i, pu); ++i) { const int r = tid >> 8, ch = (tid & 255) * 4, pm = pu.pm;
              const f32x4 u0 = *(const f32x4*)(HU + ((size_t)pm * 2 + 0) * D + ch), u1 = *(const f32x4*)(HU + ((size_t)pm * 2 + 1) * D + ch), gz = *(const f32x4*)(HG + ((size_t)pm * 2 + r) * D + ch);
              f32x4 t0 = (f32x4){0.f, 0.f, 0.f, 0.f}, t1 = t0; if (pm > 0) { t0 = *(const f32x4*)(TU + ((size_t)(pm - 1) * 2 + 0) * D + ch); t1 = *(const f32x4*)(TU + ((size_t)(pm - 1) * 2 + 1) * D + ch); }
              const f32x4 w0 = *(const f32x4*)(conv_w + ch), w1 = *(const f32x4*)(conv_w + D + ch), w2 = *(const f32x4*)(conv_w + 2 * D + ch);
              const f32x4 y = r == 0 ? gz * (w0 * t0 + w1 * t1 + w2 * u0) : gz * (w0 * t1 + w1 * u0 + w2 * u1);
              unsigned long long o = (unsigned long long)pk2(y.x, y.y) | ((unsigned long long)pk2(y.z, y.w) << 32);
              *(unsigned long long*)(Y + ((size_t)pm * 256 + r) * D + ch) = o; }
          asm volatile("s_waitcnt vmcnt(0)" ::: "memory"); __syncthreads(); }
        pg8::EpiConvOut E{XN, RMS0, conv_norm_g, X1B, SSQ};
        pg8::gemm_phase<pg8::EpiConvOut, pg8::StaticOrder, true, true>(ldsL + RING_OFF, g, S, E);
    }
    if (args.cg_seams) grid.sync(); else xcd_barrier(bar);

    if ((bx & 1) == 0) {
        typedef float f32x4m __attribute__((ext_vector_type(4)));
        LAS float* part = (LAS float*)(ldsL + RING_OFF);
        for (int chunk = bx; chunk < SEQ / 64; chunk += G) {
            const int t0 = chunk * 64, fr = lane & 15, fq = lane >> 4;
            const f32x4* sp = (const f32x4*)(SSQ + (size_t)(t0 + lane) * 16); const f32x4 sa = sp[0], sb = sp[1], sc = sp[2], sd = sp[3];
            f32x4m acc[4];
#pragma unroll
            for (int rb = 0; rb < 4; ++rb) acc[rb] = (f32x4m){0.f, 0.f, 0.f, 0.f};
#pragma unroll
            for (int ks = 0; ks < 4; ++ks) { const int k0 = wave * 128 + ks * 32 + fq * 8;
                const bf16x8 b = *(const bf16x8*)(Wft + (size_t)fr * D + k0);
#pragma unroll
                for (int rb = 0; rb < 4; ++rb) { const bf16x8 a = *(const bf16x8*)(X1B + (size_t)(t0 + rb * 16 + fr) * D + k0); acc[rb] = __builtin_amdgcn_mfma_f32_16x16x32_bf16(a, b, acc[rb], 0, 0, 0); } }
#pragma unroll
            for (int rb = 0; rb < 4; ++rb)
#pragma unroll
                for (int j = 0; j < 4; ++j) part[(wave * 64 + rb * 16 + fq * 4 + j) * 16 + fr] = acc[rb][j];
            __syncthreads();
            { const int row = t0 + lane;
              const float ss = ((sa[0] + sa[1]) + (sa[2] + sa[3])) + ((sb[0] + sb[1]) + (sb[2] + sb[3])) + ((sc[0] + sc[1]) + (sc[2] + sc[3])) + ((sd[0] + sd[1]) + (sd[2] + sd[3]));
              const float rs = 1.f / sqrtf(ss * (1.0f / 1024.0f) + RMS_EPS);
#pragma unroll
              for (int hh = 0; hh < 2; ++hh) { const int h = 2 * wave + hh; float v = 0.f;
#pragma unroll
                  for (int w = 0; w < 8; ++w) v += part[(w * 64 + lane) * 16 + h];
                  const float logit = v * rs + attn_b_f[h];
                  float lf = fminf(logit, 0.f) - 0.6931471805599453f * __builtin_amdgcn_logf(1.0f + __builtin_amdgcn_exp2f(-1.4426950408889634f * fabsf(logit)));
#pragma unroll
                  for (int o = 1; o < 64; o <<= 1) { const float y = __shfl_up(lf, o); if (lane >= o) lf += y; }
                  CL[(size_t)h * SEQ + row] = lf; if (lane == 63) TOT[h * (SEQ / 64) + chunk] = lf; } }
            asm volatile("s_waitcnt lgkmcnt(0)" ::: "memory"); __builtin_amdgcn_s_barrier(); asm volatile("" ::: "memory");
        }
    }
    {
        pg8::Gemm g{X1B, W3t, SEQ, NIN, D}; pg8::StaticOrder S; S.init(SEQ, NIN, G, bx);
        pg8::EpiAttnIn E{Qb, Kb, Vb, SZ, SSQ, q_g, k_g, attn_body::C2};
        pg8::gemm_phase<pg8::EpiAttnIn, pg8::StaticOrder, true, true>(ldsL + RING_OFF, g, S, E);
    }
    if ((bx & 1) != 0) {
        typedef float f32x4m __attribute__((ext_vector_type(4)));
        LAS float* part = (LAS float*)(ldsL + RING_OFF);
        for (int chunk = bx; chunk < SEQ / 64; chunk += G) {
            const int t0 = chunk * 64, fr = lane & 15, fq = lane >> 4;
            const f32x4* sp = (const f32x4*)(SSQ + (size_t)(t0 + lane) * 16); const f32x4 sa = sp[0], sb = sp[1], sc = sp[2], sd = sp[3];
            f32x4m acc[4];
#pragma unroll
            for (int rb = 0; rb < 4; ++rb) acc[rb] = (f32x4m){0.f, 0.f, 0.f, 0.f};
#pragma unroll
            for (int ks = 0; ks < 4; ++ks) { const int k0 = wave * 128 + ks * 32 + fq * 8;
                const bf16x8 b = *(const bf16x8*)(Wft + (size_t)fr * D + k0);
#pragma unroll
                for (int rb = 0; rb < 4; ++rb) { const bf16x8 a = *(const bf16x8*)(X1B + (size_t)(t0 + rb * 16 + fr) * D + k0); acc[rb] = __builtin_amdgcn_mfma_f32_16x16x32_bf16(a, b, acc[rb], 0, 0, 0); } }
#pragma unroll
            for (int rb = 0; rb < 4; ++rb)
#pragma unroll
                for (int j = 0; j < 4; ++j) part[(wave * 64 + rb * 16 + fq * 4 + j) * 16 + fr] = acc[rb][j];
            __syncthreads();
            { const int row = t0 + lane;
              const float ss = ((sa[0] + sa[1]) + (sa[2] + sa[3])) + ((sb[0] + sb[1]) + (sb[2] + sb[3])) + ((sc[0] + sc[1]) + (sc[2] + sc[3])) + ((sd[0] + sd[1]) + (sd[2] + sd[3]));
              const float rs = 1.f / sqrtf(ss * (1.0f / 1024.0f) + RMS_EPS);
#pragma unroll
              for (int hh = 0; hh < 2; ++hh) { const int h = 2 * wave + hh; float v = 0.f;
#pragma unroll
                  for (int w = 0; w < 8; ++w) v += part[(w * 64 + lane) * 16 + h];
                  const float logit = v * rs + attn_b_f[h];
                  float lf = fminf(logit, 0.f) - 0.6931471805599453f * __builtin_amdgcn_logf(1.0f + __builtin_amdgcn_exp2f(-1.4426950408889634f * fabsf(logit)));
#pragma unroll
                  for (int o = 1; o < 64; o <<= 1) { const float y = __shfl_up(lf, o); if (lane >= o) lf += y; }
                  CL[(size_t)h * SEQ + row] = lf; if (lane == 63) TOT[h * (SEQ / 64) + chunk] = lf; } }
            asm volatile("s_waitcnt lgkmcnt(0)" ::: "memory"); __builtin_amdgcn_s_barrier(); asm volatile("" ::: "memory");
        }
    }
        LAS int* hor = (LAS int*)(ldsL + HOR_OFF);
        float mq = 0.f, mk = 0.f;
        for (int i = 0; i < HD; ++i) { mq = fmaxf(mq, fabsf(q_g[i])); mk = fmaxf(mk, fabsf(k_g[i])); }
        const float negTH = -(20.0f + 2.0f * 8.2f * mq * mk);
        if (tid < H) { const float me = attn_b_f[tid]; int rank = 0;
            for (int h2 = 0; h2 < H; ++h2) { const float o = attn_b_f[h2]; rank += ((o > me) || (o == me && h2 < tid)) ? 1 : 0; }
            hor[rank] = tid; }
        unsigned* ctr = (unsigned*)(ws + WS_CTL) + CW_QUEUE;
        unsigned first_raw = 0u; if (wave == 0 && lane == 0) first_raw = __hip_atomic_fetch_add(ctr, 1u, __ATOMIC_RELAXED, __HIP_MEMORY_SCOPE_AGENT);
    if (args.cg_seams) grid.sync(); else xcd_barrier(bar);

    {
        LAS int* idw = (LAS int*)(ldsL + RING_OFF + attn_body::LDS_RT + 8192 + 32);
        if (wave == 0) { const int nxt = __builtin_amdgcn_readfirstlane((int)first_raw);
            if (nxt < attn_body::NUNITS) attn_body::attn_tables(__builtin_amdgcn_readfirstlane(hor[nxt >> 6]), 63 - (nxt & 63), TOT, negTH, 0, (char*)lds + RING_OFF, lane);
            if (lane == 0) idw[0] = nxt; }
        __syncthreads();
        for (int k = 0;; ++k) { const int cur = __builtin_amdgcn_readfirstlane(idw[k & 1]); if (cur >= attn_body::NUNITS) break;
            const int h = __builtin_amdgcn_readfirstlane(hor[cur >> 6]), qb = 63 - (cur & 63);
            attn_body::attn_unit<60>(h, qb, (const attn_body::bf16*)Qb, (const attn_body::bf16*)Kb, (const attn_body::bf16*)Vb, (const attn_body::bf16*)SZ, (attn_body::bf16*)OG, CL, k & 1, ctr, TOT, negTH, hor, (char*)lds + RING_OFF); }
    }
    if (args.cg_seams) grid.sync(); else xcd_barrier(bar);

    {
        pg8::Gemm g{OG, W4t, SEQ, D, D}; pg8::StaticOrder S; S.init(SEQ, D, G, bx);
        pg8::EpiOut E{X1B, out};
        pg8::gemm_phase<pg8::EpiOut, pg8::StaticOrder, true, true>(ldsL + RING_OFF, g, S, E);
    }
}

extern "C" void kernel_launch(void* const* d_in, const int* in_sizes, int n_in, void* d_out, int out_size, void* d_ws, size_t ws_size, hipStream_t stream) {
    static int grid = 0;
    if (grid == 0) {
        if (n_in != 11 ||   false || in_sizes[0] != SEQ * D || out_size != SEQ * D || ws_size < WS_END) { fprintf(stderr, "kernel_launch: unexpected shapes (n_in %d, in0 %d, out %d, ws %zu); nothing launched\n", n_in, n_in > 0 ? in_sizes[0] : -1, out_size, ws_size); grid = -1; return; }
        int dev = 0, cus = 0, per_cu = 0;
        if (hipGetDevice(&dev) != hipSuccess || hipDeviceGetAttribute(&cus, hipDeviceAttributeMultiprocessorCount, dev) != hipSuccess) { grid = -1; return; }
        if (hipFuncSetAttribute((const void*)fwd_megakernel, hipFuncAttributeMaxDynamicSharedMemorySize, LDS_BYTES) != hipSuccess) { fprintf(stderr, "kernel_launch: hipFuncSetAttribute failed\n"); grid = -1; return; }
        if (hipOccupancyMaxActiveBlocksPerMultiprocessor(&per_cu, (const void*)fwd_megakernel, NWAVES * 64, LDS_BYTES) != hipSuccess || per_cu < 1) { fprintf(stderr, "kernel_launch: occupancy query says %d\n", per_cu); per_cu = 1; }
        (void)hipGetLastError();
        grid = cus; if (grid * NWAVES < H * (SEQ / 256)) { fprintf(stderr, "kernel_launch: needs >= 128 CUs\n"); grid = -1; return; }
    }
    if (grid < 0) return;
    if (hipMemsetAsync((char*)d_ws + WS_CTL, 0, CTL_ZERO_BYTES, stream) != hipSuccess) { fprintf(stderr, "kernel_launch: hipMemsetAsync failed\n"); return; }
    Args a{};
    for (int i = 0; i < 11; ++i) a.in[i] = (const float*)d_in[i];
    a.out = (float*)d_out; a.ws = (unsigned char*)d_ws; a.cg_seams = 0; a.pad = 0;
    void* kargs[] = {&a};
    hipError_t e = hipLaunchCooperativeKernel((const void*)fwd_megakernel, dim3(grid), dim3(NWAVES * 64), kargs, LDS_BYTES, stream);
    if (e != hipSuccess) fprintf(stderr, "kernel_launch: cooperative launch failed: %s (grid %d)\n", hipGetErrorString(e), grid);
}
```
